# Optimizing an MI355X kernel written in HIP

```python
import jax, jax.numpy as jnp
from jax import lax
import numpy as np

D_MODEL = 1024
BATCH = 4
SEQ = 4096
DEPTH = 2

CHUNK = 64
Q_BLOCK = 128
EPS = 1e-6

A_HEADS = 8
A_NOPE = 64
A_ROPE = 32
A_VDIM = 64
A_QLORA = 256
A_KVLORA = 128
ROPE_THETA = 10000.0

B_HEADS = 4
B_DIM = 64

POOL_WINDOWS = (2, 4, 8, 16)
POOL_CH = 64

A_WIDTH = A_HEADS * A_VDIM
B_WIDTH = B_HEADS * B_DIM
C_WIDTH = len(POOL_WINDOWS) * POOL_CH
D_MIX = A_WIDTH + B_WIDTH + C_WIDTH

A_IN = A_QLORA + A_KVLORA + A_ROPE
B_IN = 3 * B_WIDTH
D_IN = A_IN + B_IN + C_WIDTH

N_GROUPS = 4
EXPERTS_PER_GROUP = 8
TOP_K_INNER = 2
D_EXPERT = 256

kernel_name = 'hybrid_mla_stickbreak_pool_hmoe'


def rms_norm(x, g):
    xf = x.astype(jnp.float32)
    y = xf * lax.rsqrt(jnp.mean(xf * xf, axis=-1, keepdims=True) + EPS)
    return (y * g.astype(jnp.float32)).astype(x.dtype)


def rope_tables(seq):
    pos = jnp.arange(seq, dtype=jnp.float32)
    inv = ROPE_THETA ** (-jnp.arange(0, A_ROPE, 2, dtype=jnp.float32) / A_ROPE)
    ang = pos[:, None] * inv[None, :]
    return jnp.cos(ang), jnp.sin(ang)


def apply_rope(x, cos, sin):
    half = x.shape[-1] // 2
    x1 = x[..., :half].astype(jnp.float32)
    x2 = x[..., half:].astype(jnp.float32)
    out = jnp.concatenate([x1 * cos - x2 * sin, x2 * cos + x1 * sin], axis=-1)
    return out.astype(x.dtype)


def mla_mixer(c_q, c_kv, k_r, q_norm_g, w_uq, kv_norm_g, w_ukv):
    B, S, _ = c_q.shape
    cos, sin = rope_tables(S)
    q = jnp.einsum('bsr,rf->bsf', rms_norm(c_q, q_norm_g), w_uq).reshape(B, S, A_HEADS, A_NOPE + A_ROPE)
    q = jnp.concatenate([q[..., :A_NOPE], apply_rope(q[..., A_NOPE:], cos[None, :, None], sin[None, :, None])], axis=-1)
    kv = jnp.einsum('bsr,rf->bsf', rms_norm(c_kv, kv_norm_g), w_ukv).reshape(B, S, A_HEADS, A_NOPE + A_VDIM)
    k_rope = apply_rope(k_r, cos[None], sin[None])
    k = jnp.concatenate([kv[..., :A_NOPE], jnp.broadcast_to(k_rope[:, :, None, :], (B, S, A_HEADS, A_ROPE))], axis=-1)
    v = kv[..., A_NOPE:]
    scale = (A_NOPE + A_ROPE) ** -0.5
    chunk_id = jnp.arange(S) // CHUNK
    outs = []
    for i in range(S // Q_BLOCK):
        q0, q1 = i * Q_BLOCK, (i + 1) * Q_BLOCK
        s = jnp.einsum('bqhd,bkhd->bhqk', q[:, q0:q1], k[:, :q1]).astype(jnp.float32) * scale
        allowed = chunk_id[:q1][None, :] <= chunk_id[q0:q1][:, None]
        s = jnp.where(allowed, s, -1e30)
        p = jax.nn.softmax(s, axis=-1).astype(v.dtype)
        outs.append(jnp.einsum('bhqk,bkhd->bqhd', p, v[:, :q1]))
    return jnp.concatenate(outs, axis=1).reshape(B, S, A_WIDTH)


def stick_breaking_mixer(q, k, v):
    B, S = q.shape[0], q.shape[1]
    pos = jnp.arange(S)
    scale = B_DIM ** -0.5
    outs = []
    for i in range(S // Q_BLOCK):
        q0, q1 = i * Q_BLOCK, (i + 1) * Q_BLOCK
        z = jnp.einsum('bqhd,bkhd->bhqk', q[:, q0:q1], k[:, :q1]).astype(jnp.float32) * scale
        strict = pos[:q1][None, :] < pos[q0:q1][:, None]
        log_1m_beta = jnp.where(strict, -jax.nn.softplus(z), 0.0)
        between = lax.cumsum(log_1m_beta, axis=3, reverse=True) - log_1m_beta
        a = jnp.where(strict, jnp.exp(jax.nn.log_sigmoid(z) + between), 0.0).astype(v.dtype)
        outs.append(jnp.einsum('bhqk,bkhd->bqhd', a, v[:, :q1]))
    return jnp.concatenate(outs, axis=1).reshape(B, S, B_WIDTH)


def pool_mixer(u, pool_w, pool_scale):
    B, S, _ = u.shape
    uf = u.astype(jnp.float32)
    cs = jnp.concatenate([jnp.zeros((B, 1, C_WIDTH), jnp.float32), jnp.cumsum(uf, axis=1)], axis=1)
    pos = jnp.arange(S, dtype=jnp.float32)
    groups = []
    for g, w in enumerate(POOL_WINDOWS):
        c = cs[..., g * POOL_CH:(g + 1) * POOL_CH]
        lag = jnp.pad(c[:, :S - w + 1], ((0, 0), (w - 1, 0), (0, 0)))
        count = jnp.minimum(pos + 1.0, float(w))[None, :, None]
        mean = (c[:, 1:] - lag) / count
        groups.append(mean - uf[..., g * POOL_CH:(g + 1) * POOL_CH])
    d = jnp.stack(groups, axis=2).astype(u.dtype)
    y = jnp.einsum('bsgc,gcd->bsgd', d, pool_w).reshape(B, S, C_WIDTH)
    return y * pool_scale


def hier_moe(h, w_group, b_group, w_expert, b_expert, w_gate, w_up, w_down):
    B, S, D = h.shape
    t = h.reshape(B * S, D)
    g_prob = jax.nn.softmax((t @ w_group + b_group).astype(jnp.float32), axis=-1)
    p_sel, g_idx = lax.top_k(g_prob, 1)
    p_sel, g_idx = p_sel[:, 0], g_idx[:, 0]
    e_logits = (t @ w_expert + b_expert).astype(jnp.float32).reshape(B * S, N_GROUPS, EXPERTS_PER_GROUP)
    e_in = jnp.take_along_axis(e_logits, g_idx[:, None, None], axis=1)[:, 0]
    e_prob = jax.nn.softmax(e_in, axis=-1)
    w_k, i_k = lax.top_k(e_prob, TOP_K_INNER)
    w_k = w_k / jnp.sum(w_k, axis=-1, keepdims=True)
    inner = jnp.sum(jax.nn.one_hot(i_k, EXPERTS_PER_GROUP, dtype=jnp.float32) * w_k[..., None], axis=1)
    combine = (p_sel[:, None, None] * jax.nn.one_hot(g_idx, N_GROUPS, dtype=jnp.float32)[:, :, None]
               * inner[:, None, :]).astype(t.dtype)
    y = jnp.zeros_like(t)
    for g in range(N_GROUPS):
        a = jnp.einsum('nd,edf->nef', t, w_gate[g])
        b = jnp.einsum('nd,edf->nef', t, w_up[g])
        hid = jax.nn.silu(a) * b * combine[:, g, :, None]
        y = y + jnp.einsum('nef,efd->nd', hid, w_down[g])
    return y.reshape(B, S, D)


def hybrid_layer(x, norm1_g, w_in, q_norm_g, w_uq, kv_norm_g, w_ukv, pool_w, pool_scale, w_out,
                 norm2_g, w_group, b_group, w_expert, b_expert, w_gate, w_up, w_down):
    B, S, _ = x.shape
    hn = rms_norm(x, norm1_g)
    proj = jnp.einsum('bsd,df->bsf', hn, w_in)
    o1 = A_QLORA
    o2 = o1 + A_KVLORA
    o3 = o2 + A_ROPE
    o4 = o3 + B_IN
    ya = mla_mixer(proj[..., :o1], proj[..., o1:o2], proj[..., o2:o3], q_norm_g, w_uq, kv_norm_g, w_ukv)
    qkv_b = proj[..., o3:o4].reshape(B, S, 3, B_HEADS, B_DIM)
    yb = stick_breaking_mixer(qkv_b[:, :, 0], qkv_b[:, :, 1], qkv_b[:, :, 2])
    yc = pool_mixer(proj[..., o4:], pool_w, pool_scale)
    mixed = jnp.concatenate([ya, yb, yc], axis=-1)
    x = x + jnp.einsum('bsm,md->bsd', mixed, w_out)
    x = x + hier_moe(rms_norm(x, norm2_g), w_group, b_group, w_expert, b_expert, w_gate, w_up, w_down)
    return x


def setup_inputs(seed: int = 0) -> dict:
    key = jax.random.key(seed)
    ks = jax.random.split(key, 20)
    L, D = DEPTH, D_MODEL

    def nrm(k, shape, fan_in):
        return jax.random.normal(k, shape, jnp.float32) * (fan_in ** -0.5)

    def gain(k, shape):
        return 1.0 + 0.02 * jax.random.normal(k, shape, jnp.float32)

    return {
        'x': jax.random.normal(ks[0], (BATCH, SEQ, D), jnp.float32),
        'norm1_g': gain(ks[1], (L, D)),
        'w_in': nrm(ks[2], (L, D, D_IN), D),
        'q_norm_g': gain(ks[3], (L, A_QLORA)),
        'w_uq': nrm(ks[4], (L, A_QLORA, A_HEADS * (A_NOPE + A_ROPE)), A_QLORA),
        'kv_norm_g': gain(ks[5], (L, A_KVLORA)),
        'w_ukv': nrm(ks[6], (L, A_KVLORA, A_HEADS * (A_NOPE + A_VDIM)), A_KVLORA),
        'pool_w': nrm(ks[7], (L, len(POOL_WINDOWS), POOL_CH, POOL_CH), POOL_CH),
        'pool_scale': gain(ks[8], (L, C_WIDTH)),
        'w_out': nrm(ks[9], (L, D_MIX, D), D_MIX),
        'norm2_g': gain(ks[10], (L, D)),
        'w_group': nrm(ks[11], (L, D, N_GROUPS), D),
        'b_group': 0.01 * jax.random.normal(ks[12], (L, N_GROUPS), jnp.float32),
        'w_expert': nrm(ks[13], (L, D, N_GROUPS * EXPERTS_PER_GROUP), D),
        'b_expert': 0.01 * jax.random.normal(ks[14], (L, N_GROUPS * EXPERTS_PER_GROUP), jnp.float32),
        'w_gate': nrm(ks[15], (L, N_GROUPS, EXPERTS_PER_GROUP, D, D_EXPERT), D),
        'w_up': nrm(ks[16], (L, N_GROUPS, EXPERTS_PER_GROUP, D, D_EXPERT), D),
        'w_down': nrm(ks[17], (L, N_GROUPS, EXPERTS_PER_GROUP, D_EXPERT, D), D_EXPERT),
        'final_g': gain(ks[18], (D,)),
    }


def reference(x, norm1_g, w_in, q_norm_g, w_uq, kv_norm_g, w_ukv, pool_w, pool_scale, w_out,
              norm2_g, w_group, b_group, w_expert, b_expert, w_gate, w_up, w_down, final_g):
    for l in range(DEPTH):
        x = hybrid_layer(x, norm1_g[l], w_in[l], q_norm_g[l], w_uq[l], kv_norm_g[l], w_ukv[l],
                         pool_w[l], pool_scale[l], w_out[l], norm2_g[l], w_group[l], b_group[l],
                         w_expert[l], b_expert[l], w_gate[l], w_up[l], w_down[l])
    return rms_norm(x, final_g)
```

```cpp
#include <hip/hip_runtime.h>
#include <cstdio>
#include <cstdint>

#ifndef MK_N_LAUNCHES
#define MK_N_LAUNCHES 1
#endif

#define GAS __attribute__((address_space(1)))
#define LAS __attribute__((address_space(3)))
typedef unsigned short bf16;
typedef unsigned v4u __attribute__((ext_vector_type(4)));
typedef float f32x4 __attribute__((ext_vector_type(4)));
typedef GAS unsigned gu32;
#define RLX_AGENT __ATOMIC_RELAXED, __HIP_MEMORY_SCOPE_AGENT
#define LDS_WAIT() asm volatile("s_waitcnt lgkmcnt(0)" ::: "memory")

constexpr int DM = 1024, NBATCH = 4, SEQ = 4096, NTOK = NBATCH * SEQ, DEPTH = 2;
constexpr int AH = 8, AQL = 256, AKVL = 128;
constexpr int BHD = 4;
constexpr int DIN = 1440, NPAD = 1536;
constexpr int NEXP = 32, DE = 256;
constexpr float EPS = 1e-6f;
constexpr float LOG2E = 1.4426950408889634f;
constexpr float QSCALE_A = 0.10206207261596575f * LOG2E;
constexpr float QSCALE_B = 0.125f * LOG2E;
constexpr int NWAVES = 8, NTHREADS = 512;
constexpr int RMAX = 40960;

constexpr size_t MiB = 1u << 20;
constexpr size_t WS_CTL = 0, CTL_ZERO_BYTES = 256 * 1024;
constexpr size_t WS_ROPE = 512 * 1024;
constexpr size_t WS_WR = 1 * MiB;
constexpr size_t WO_IN = 0, WO_UQ = 1572864, WO_UKV = WO_UQ + 196608, WO_OUT = WO_UKV + 262144, WO_GU = WO_OUT + 1048576, WO_D = WO_GU + 16777216, WO_END = WO_D + 8388608;
constexpr size_t WL_BYTES = WO_END * 2;
constexpr size_t P_W = 2 * MiB;
constexpr size_t SM_RINV = 0, SM_R2 = 65536, SM_RTE = 131072, SM_RTPOS = 262144, SM_RTC = 393216, SM_TROW = 524288, SM_SSQQ = 655360, SM_SSQKV = 917504,
                 SM_ROWR2 = 1179648, SM_ROWC = 1343488, SM_ROWTOK = 1507328, SM_END = 1671168;
static_assert(SM_END <= 2 * MiB, "small");
constexpr size_t F_XB = 110 * MiB, F_SMALL = 142 * MiB, F_KR = 144 * MiB, F_U = 145 * MiB, F_SBQ = 153 * MiB, F_SBK = 161 * MiB, F_SBVT = 169 * MiB,
                 F_Q = 177 * MiB, F_KN = 201 * MiB, F_VT = 217 * MiB, F_CQ = 233 * MiB, F_CKVX = 241 * MiB, F_MIX = 233 * MiB, F_END = 265 * MiB;
constexpr size_t F_H = 144 * MiB, F_Y = 164 * MiB;
static_assert(F_Y + (size_t)RMAX * 1024 * 2 <= F_END, "moe overlay");
static_assert(P_W + 2 * WL_BYTES <= F_XB, "weights fit");

constexpr int CW_BAR = 1024;
constexpr int CW_CNT = 8192;

constexpr int LDS_BYTES = 147456;
constexpr int MISC_OFF = 131072 + 320;

__device__ __forceinline__ float bf2f(bf16 v) { return __uint_as_float(((unsigned)v) << 16); }
__device__ __forceinline__ float bflo(unsigned w) { return __uint_as_float(w << 16); }
__device__ __forceinline__ float bfhi(unsigned w) { return __uint_as_float(w & 0xffff0000u); }
__device__ __forceinline__ unsigned f2bf(float f) { unsigned u = __float_as_uint(f); return (u + 0x7fffu + ((u >> 16) & 1u)) >> 16; }
__device__ __forceinline__ unsigned pk2(float lo, float hi) { return f2bf(lo) | (f2bf(hi) << 16); }
__device__ __forceinline__ float wave_sum(float v) {
#pragma unroll
    for (int o = 1; o < 64; o <<= 1) v += __shfl_xor(v, o);
    return v;
}
__device__ __forceinline__ int perm16(int t) { return (t & ~15) | (t & 3) | ((t & 8) >> 1) | ((t & 4) << 1); }
__device__ __forceinline__ size_t idx_KR(int b, int s, int i) { return ((((size_t)b * 64 + (s >> 6)) * 4 + (i >> 3)) * 64 + (s & 63)) * 8 + (i & 7); }
__device__ __forceinline__ size_t idx_KN(int b, int h, int s, int d) { return (((((size_t)b * 8 + h) * 64 + (s >> 6)) * 8 + (d >> 3)) * 64 + (s & 63)) * 8 + (d & 7); }
__device__ __forceinline__ size_t idx_Q(int b, int h, int s, int d) { return (((size_t)b * 8 + h) * SEQ + s) * 96 + d; }
__device__ __forceinline__ size_t idx_SB(int b, int h, int s, int d) { return (((size_t)b * 4 + h) * SEQ + s) * 64 + d; }

__device__ __forceinline__ float dot_bf16(const bf16* a, const bf16* b, int n) {
    float acc = 0.f;
    for (int k = 0; k < n; k += 8) {
        const v4u x = *(const v4u*)(a + k), y = *(const v4u*)(b + k);
        acc += bflo(x.x) * bflo(y.x) + bfhi(x.x) * bfhi(y.x) + bflo(x.y) * bflo(y.y) + bfhi(x.y) * bfhi(y.y)
             + bflo(x.z) * bflo(y.z) + bfhi(x.z) * bfhi(y.z) + bflo(x.w) * bflo(y.w) + bfhi(x.w) * bfhi(y.w);
    }
    return acc;
}

#define XB_TMO      128
#define XB_XCNT(j)  (256  + 64 * (j))
#define XB_XSUB(j)  (1280 + 64 * (j))
#define XB_XGEN(j)  (2304 + 64 * (j))
#define XB_TOP      3328
#define XB_TOPGEN   3392
#define XCD_BAR_WORDS 3456
#define XB_SPIN_CAP (1u << 22)
__device__ __forceinline__ unsigned xb_ld(unsigned* p)              { return __hip_atomic_load(p, __ATOMIC_RELAXED, __HIP_MEMORY_SCOPE_AGENT); }
__device__ __forceinline__ unsigned xb_add(unsigned* p, unsigned v) { return __hip_atomic_fetch_add(p, v, __ATOMIC_RELAXED, __HIP_MEMORY_SCOPE_AGENT); }
__device__ __forceinline__ unsigned xb_xcc_id() { return (unsigned)__builtin_amdgcn_s_getreg((3 << 11) | 20) & 0xFu; }
#define XB_SPIN(cond, bar) do { unsigned _sp = 0; while (cond) { __builtin_amdgcn_s_sleep(1); \
    if ((++_sp & 255u) == 0u) { if (xb_ld(&(bar)[XB_TMO])) break; if (_sp > XB_SPIN_CAP) { atomicAdd(&(bar)[XB_TMO], 1u); break; } } } } while (0)
struct XcdBarrier { unsigned* bar; unsigned x; volatile LAS unsigned* st; };
__device__ __forceinline__ XcdBarrier xcd_barrier_post(unsigned* bar, volatile LAS unsigned* st) {
    XcdBarrier b; b.bar = bar; b.x = xb_xcc_id(); b.st = st;
    if (threadIdx.x == 0) (void)xb_add(&bar[XB_XCNT(b.x)], 1u);
    return b;
}
__device__ __forceinline__ void xcd_barrier_complete(unsigned* bar, unsigned x, unsigned& nloc, unsigned& nx) {
    const unsigned G = gridDim.x * gridDim.y * gridDim.z;
    unsigned sum, cnt, mine, sp = 0u;
    for (;;) {
        sum = 0u; cnt = 0u; mine = 0u;
#pragma unroll
        for (unsigned j = 0; j < 16; ++j) { const unsigned c = xb_ld(&bar[XB_XCNT(j)]); sum += c; cnt += (c > 0u) ? 1u : 0u; mine = (j == x) ? c : mine; }
        if (sum == G) break;
        __builtin_amdgcn_s_sleep(1);
        if ((++sp & 255u) == 0u) { if (xb_ld(&bar[XB_TMO])) break; if (sp > XB_SPIN_CAP) { atomicAdd(&bar[XB_TMO], 1u); break; } }
    }
    nloc = mine > 0u ? mine : 1u; nx = cnt > 0u ? cnt : 1u;
}
__device__ __forceinline__ void xcd_barrier(const XcdBarrier& b) {
    asm volatile("s_waitcnt vmcnt(0)" ::: "memory");
    __syncthreads();
    if (threadIdx.x == 0) {
        unsigned* bar = b.bar;
        __builtin_amdgcn_s_waitcnt(0);
        unsigned nloc = b.st[0], nx = b.st[1];
        if (nloc == 0u) { xcd_barrier_complete(bar, b.x, nloc, nx); b.st[0] = nloc; b.st[1] = nx; }
        const unsigned old = xb_add(&bar[XB_XSUB(b.x)], 1u);
        const unsigned gen = old / nloc;
        if (old + 1u == (gen + 1u) * nloc) {
            __builtin_amdgcn_fence(__ATOMIC_RELEASE, "agent");
            asm volatile("s_waitcnt vmcnt(0)" ::: "memory");
            const unsigned og = xb_add(&bar[XB_TOP], 1u);
            const unsigned tg = og / nx;
            if (og + 1u == (tg + 1u) * nx) xb_add(&bar[XB_TOPGEN], 1u);
            else XB_SPIN(xb_ld(&bar[XB_TOPGEN]) == tg, bar);
            __builtin_amdgcn_fence(__ATOMIC_ACQUIRE, "agent");
            xb_add(&bar[XB_XGEN(b.x)], 1u);
            asm volatile("s_waitcnt vmcnt(0)" ::: "memory");
        } else {
            XB_SPIN(xb_ld(&bar[XB_XGEN(b.x)]) == gen, bar);
            __builtin_amdgcn_fence(__ATOMIC_ACQUIRE, "agent");
            asm volatile("s_waitcnt vmcnt(0)" ::: "memory");
        }
    }
    __syncthreads();
}

struct Frame {
    LAS unsigned char* lds;
    unsigned* ctl;
    int tid, lane, wave, gtid, gw;
    const float* in[19];
    float* X;
    unsigned char* ws;
};
constexpr int GT = 256 * NTHREADS, NGW = 256 * NWAVES;

__device__ __forceinline__ bf16* wl(const Frame& F, int l, size_t off) { return (bf16*)(F.ws + P_W + (size_t)l * WL_BYTES) + off; }
#define PTR(type, off) ((type*)(F.ws + (off)))
#define SMALLP(type, off) ((type*)(F.ws + F_SMALL + (off)))

__device__ __forceinline__ void transpose_item(const float* W, int ldw, int k0, int c0, bf16* WT, int ldt, int drow, const float* gain, LAS float* scr, int lane) {
#pragma unroll 8
    for (int i = 0; i < 32; ++i) { const int kk = 2 * i + (lane >> 5); float v = W[(size_t)(k0 + kk) * ldw + c0 + (lane & 31)]; if (gain) v *= gain[k0 + kk]; scr[kk * 33 + (lane & 31)] = v; }
    LDS_WAIT(); asm volatile("" ::: "memory");
    const int c = lane & 7;
#pragma unroll
    for (int j = 0; j < 4; ++j) { const int n = (lane >> 3) + 8 * j; const LAS float* s = scr + (8 * c) * 33 + n;
        v4u o; o.x = pk2(s[0 * 33], s[1 * 33]); o.y = pk2(s[2 * 33], s[3 * 33]); o.z = pk2(s[4 * 33], s[5 * 33]); o.w = pk2(s[6 * 33], s[7 * 33]);
        *(v4u*)(WT + (size_t)(drow + n) * ldt + k0 + 8 * c) = o; }
    LDS_WAIT(); asm volatile("" ::: "memory");
}
constexpr int IT_IN = 16 * 45, IT_UQ = 4 * 24, IT_UKV = 2 * 32, IT_OUT = 16 * 32, IT_G = 32 * 16 * 8, IT_D = 32 * 4 * 32;
constexpr int IT_LAYER = IT_IN + IT_UQ + IT_UKV + IT_OUT + 2 * IT_G + IT_D;
__device__ __forceinline__ void p0_item(const Frame& F, int it, LAS float* scr) {
    const int l = it / IT_LAYER; int r = it % IT_LAYER; const int lane = F.lane;
    if (r < IT_IN) { const int kb = r / 45, cb = r % 45, c0 = 32 * cb;
        const int drow = c0 < 416 ? c0 : c0 < 672 ? 512 + (c0 - 416) : c0 < 928 ? 768 + (c0 - 672) : c0 < 1184 ? 1280 + (c0 - 928) : 1024 + (c0 - 1184);
        transpose_item(F.in[2] + (size_t)l * DM * DIN, DIN, 64 * kb, c0, wl(F, l, WO_IN), 1024, drow, F.in[1] + l * DM, scr, lane); return; } r -= IT_IN;
    if (r < IT_UQ) { const int kb = r / 24, cb = r % 24, h = cb / 3, p = cb % 3; const int drow = p < 2 ? 64 * h + 32 * p : 512 + 32 * h;
        transpose_item(F.in[4] + (size_t)l * AQL * 768, 768, 64 * kb, 32 * cb, wl(F, l, WO_UQ), 256, drow, F.in[3] + l * AQL, scr, lane); return; } r -= IT_UQ;
    if (r < IT_UKV) { const int kb = r / 32, cb = r % 32, h = cb / 4, p = cb % 4; const int drow = p < 2 ? 64 * h + 32 * p : 512 + 64 * h + 32 * (p - 2);
        transpose_item(F.in[6] + (size_t)l * AKVL * 1024, 1024, 64 * kb, 32 * cb, wl(F, l, WO_UKV), 256, drow, F.in[5] + l * AKVL, scr, lane); return; } r -= IT_UKV;
    if (r < IT_OUT) { const int kb = r / 32, cb = r % 32;
        transpose_item(F.in[9] + (size_t)l * DM * DM, DM, 64 * kb, 32 * cb, wl(F, l, WO_OUT), 1024, 32 * cb, nullptr, scr, lane); return; } r -= IT_OUT;
    if (r < 2 * IT_G) { const int up = r / IT_G; r %= IT_G; const int e = r / 128, q = r % 128, kb = q / 8, cb = q % 8;
        const int drow = e * 512 + 256 * (cb >> 2) + 32 * (cb & 3) + 128 * up;
        transpose_item((up ? F.in[16] : F.in[15]) + ((size_t)l * NEXP + e) * DM * DE, DE, 64 * kb, 32 * cb, wl(F, l, WO_GU), 1024, drow, F.in[10] + l * DM, scr, lane); return; } r -= 2 * IT_G;
    { const int e = r / 128, q = r % 128, kb = q / 32, cb = q % 32;
        transpose_item(F.in[17] + ((size_t)l * NEXP + e) * DE * DM, DM, 64 * kb, 32 * cb, wl(F, l, WO_D), 256, e * 1024 + 32 * cb, nullptr, scr, lane); }
}
__device__ __forceinline__ void row_to_bf16_rinv(const Frame& F, const float* xrow, bf16* orow, float* rinv) {
    const f32x4* xr = (const f32x4*)xrow + F.lane;
    f32x4 v[4]; float s = 0.f;
#pragma unroll
    for (int j = 0; j < 4; ++j) { v[j] = xr[64 * j]; s += (v[j].x * v[j].x + v[j].y * v[j].y) + (v[j].z * v[j].z + v[j].w * v[j].w); }
    s = wave_sum(s);
    if (F.lane == 0) *rinv = 1.0f / sqrtf(s * (1.0f / DM) + EPS);
    unsigned long long* o8 = (unsigned long long*)orow + F.lane;
#pragma unroll
    for (int j = 0; j < 4; ++j) o8[64 * j] = (unsigned long long)pk2(v[j].x, v[j].y) | ((unsigned long long)pk2(v[j].z, v[j].w) << 32);
}
__device__ __forceinline__ void phase_p0(const Frame& F) {
    LAS float* scr = (LAS float*)(F.lds + F.wave * 16384);
    for (int it = F.gw; it < DEPTH * IT_LAYER; it += NGW) p0_item(F, it, scr);
    for (int l = 0; l < DEPTH; ++l) {
        v4u z = {0u, 0u, 0u, 0u};
        for (int i = F.gtid; i < 96 * 1024 / 8; i += GT) *(v4u*)(wl(F, l, WO_IN) + (size_t)416 * 1024 + (size_t)i * 8) = z;
        for (int i = F.gtid; i < 1024 * 16; i += GT) { const int n = i >> 4, c = i & 15; *(v4u*)(wl(F, l, WO_UKV) + (size_t)n * 256 + 128 + c * 8) = z; }
        float* wr = PTR(float, WS_WR) + (size_t)l * 40 * 1024;
        for (int i = F.gtid; i < 40 * 1024; i += GT) { const int j = i >> 10, k = i & 1023; float v = 0.f;
            if (j < 4) v = F.in[11][((size_t)l * DM + k) * 4 + j]; else if (j < 36) v = F.in[13][((size_t)l * DM + k) * 32 + (j - 4)];
            wr[i] = v * F.in[10][l * DM + k]; }
    }
    float* rope = PTR(float, WS_ROPE);
    for (int i = F.gtid; i < SEQ * 16; i += GT) { const int s = i >> 4, j = i & 15;
        const float inv = exp2f(-(float)(2 * j) * (1.0f / 32.0f) * 13.287712379549449f);
        const float ang = (float)s * inv;
        const double rev = (double)ang * 0.15915494309189535; const double fr = rev - floor(rev);
        const double a = fr * 6.283185307179586;
        rope[2 * i] = (float)cos(a); rope[2 * i + 1] = (float)sin(a); }
    bf16* xb = PTR(bf16, F_XB); float* rinv = SMALLP(float, SM_RINV);
    for (int m = F.gw; m < NTOK; m += NGW) row_to_bf16_rinv(F, F.in[0] + (size_t)m * DM, xb + (size_t)m * DM, rinv + m);
}

__device__ __forceinline__ void phase_a1(const Frame& F, int l) {
    const bf16* xb = PTR(bf16, F_XB); const bf16* w = wl(F, l, WO_IN); const float* rinv = SMALLP(float, SM_RINV); const float* rope = PTR(float, WS_ROPE);
    bf16* CQ = PTR(bf16, F_CQ); bf16* CKVX = PTR(bf16, F_CKVX); bf16* KR = PTR(bf16, F_KR); bf16* U = PTR(bf16, F_U); bf16* SBQ = PTR(bf16, F_SBQ); bf16* SBK = PTR(bf16, F_SBK); bf16* SBVT = PTR(bf16, F_SBVT);
    float* SSQQ = SMALLP(float, SM_SSQQ); float* SSQKV = SMALLP(float, SM_SSQKV);
    for (size_t idx = F.gtid; idx < (size_t)NTOK * NPAD; idx += GT) {
        const int t = (int)(idx / NPAD), n = (int)(idx % NPAD), b = t >> 12, s = t & 4095;
        float val = 0.f;
        if (!(n >= 416 && n < 512)) val = dot_bf16(xb + (size_t)t * DM, w + (size_t)n * DM, DM) * rinv[t];
        const float other = __shfl_xor(val, 16);
        if (n < 256) { CQ[(size_t)t * 256 + n] = (bf16)f2bf(val); const float q = wave_sum(val * val); if (F.lane == 0) SSQQ[t * 4 + (n >> 6)] = q; }
        else if (n < 512) { CKVX[(size_t)t * 256 + (n - 256)] = (bf16)f2bf(val);
            if (n < 384) { const float q = wave_sum(val * val); if (F.lane == 0) { SSQKV[t * 4 + ((n - 256) >> 6)] = q; SSQKV[t * 4 + 2 + ((n - 256) >> 6)] = 0.f; } }
            else if (n < 416) { const int i = n - 384, j = i & 15; const float c = rope[(s * 16 + j) * 2], sn = rope[(s * 16 + j) * 2 + 1];
                const float o = i < 16 ? val * c - other * sn : val * c + other * sn; KR[idx_KR(b, s, i)] = (bf16)f2bf(o); } }
        else if (n < 768) { const int h = (n - 512) >> 6, d = (n - 512) & 63; SBQ[idx_SB(b, h, s, d)] = (bf16)f2bf(val * QSCALE_B); }
        else if (n < 1024) { const int h = (n - 768) >> 6, d = (n - 768) & 63; SBK[idx_SB(b, h, s, d)] = (bf16)f2bf(val); }
        else if (n < 1280) { U[(size_t)t * 256 + (n - 1024)] = (bf16)f2bf(val); }
        else { SBVT[(size_t)(n - 1280) * NTOK + perm16(t)] = (bf16)f2bf(val); }
    }
}

__device__ __forceinline__ void phase_a2(const Frame& F, int l) {
    const bf16* CQ = PTR(bf16, F_CQ); const bf16* CKVX = PTR(bf16, F_CKVX); const float* SSQQ = SMALLP(float, SM_SSQQ); const float* SSQKV = SMALLP(float, SM_SSQKV); const float* rope = PTR(float, WS_ROPE);
    bf16* Q = PTR(bf16, F_Q); bf16* KN = PTR(bf16, F_KN); bf16* VT = PTR(bf16, F_VT);
    const bf16* wq = wl(F, l, WO_UQ); const bf16* wkv = wl(F, l, WO_UKV);
    for (size_t idx = F.gtid; idx < (size_t)NTOK * 768; idx += GT) {
        const int t = (int)(idx / 768), n = (int)(idx % 768), b = t >> 12, s = t & 4095;
        const float rq = 1.0f / sqrtf((SSQQ[t * 4] + SSQQ[t * 4 + 1] + SSQQ[t * 4 + 2] + SSQQ[t * 4 + 3]) * (1.0f / AQL) + EPS);
        const float val = dot_bf16(CQ + (size_t)t * 256, wq + (size_t)n * 256, 256) * rq;
        const float other = __shfl_xor(val, 16);
        if (n < 512) { Q[idx_Q(b, n >> 6, s, n & 63)] = (bf16)f2bf(val * QSCALE_A); }
        else { const int h = (n - 512) >> 5, i = (n - 512) & 31, j = i & 15; const float c = rope[(s * 16 + j) * 2], sn = rope[(s * 16 + j) * 2 + 1];
            const float o = i < 16 ? val * c - other * sn : val * c + other * sn; Q[idx_Q(b, h, s, 64 + i)] = (bf16)f2bf(o * QSCALE_A); }
    }
    for (size_t idx = F.gtid; idx < (size_t)NTOK * 1024; idx += GT) {
        const int t = (int)(idx >> 10), n = (int)(idx & 1023), b = t >> 12, s = t & 4095;
        const float rkv = 1.0f / sqrtf((SSQKV[t * 4] + SSQKV[t * 4 + 1] + SSQKV[t * 4 + 2] + SSQKV[t * 4 + 3]) * (1.0f / AKVL) + EPS);
        const float val = dot_bf16(CKVX + (size_t)t * 256, wkv + (size_t)n * 256, 256) * rkv;
        if (n < 512) KN[idx_KN(b, n >> 6, s, n & 63)] = (bf16)f2bf(val);
        else VT[(size_t)(n - 512) * NTOK + perm16(t)] = (bf16)f2bf(val);
    }
}

__device__ __forceinline__ void phase_a3(const Frame& F, int l) {
    const bf16* Q = PTR(bf16, F_Q); const bf16* KN = PTR(bf16, F_KN); const bf16* VT = PTR(bf16, F_VT); const bf16* KR = PTR(bf16, F_KR);
    const bf16* SBQ = PTR(bf16, F_SBQ); const bf16* SBK = PTR(bf16, F_SBK); const bf16* SBVT = PTR(bf16, F_SBVT); const bf16* U = PTR(bf16, F_U);
    bf16* MIX = PTR(bf16, F_MIX);
    for (int idx = F.gtid; idx < NBATCH * AH * SEQ; idx += GT) {
        const int s = idx & 4095, h = (idx >> 12) & 7, b = idx >> 15;
        unsigned qp[48];
#pragma unroll
        for (int i = 0; i < 12; ++i) { const v4u v = *(const v4u*)(Q + idx_Q(b, h, s, 8 * i)); qp[4 * i] = v.x; qp[4 * i + 1] = v.y; qp[4 * i + 2] = v.z; qp[4 * i + 3] = v.w; }
        float acc[64];
#pragma unroll
        for (int d = 0; d < 64; ++d) acc[d] = 0.f;
        float m = -INFINITY, lsum = 0.f;
        const int nkeys = ((s >> 6) + 1) * 64;
        for (int key = 0; key < nkeys; ++key) {
            float sc = 0.f;
#pragma unroll
            for (int c = 0; c < 8; ++c) { const v4u kv = *(const v4u*)(KN + idx_KN(b, h, key, 8 * c));
                sc += bflo(qp[4 * c]) * bflo(kv.x) + bfhi(qp[4 * c]) * bfhi(kv.x) + bflo(qp[4 * c + 1]) * bflo(kv.y) + bfhi(qp[4 * c + 1]) * bfhi(kv.y)
                    + bflo(qp[4 * c + 2]) * bflo(kv.z) + bfhi(qp[4 * c + 2]) * bfhi(kv.z) + bflo(qp[4 * c + 3]) * bflo(kv.w) + bfhi(qp[4 * c + 3]) * bfhi(kv.w); }
#pragma unroll
            for (int c = 0; c < 4; ++c) { const v4u kv = *(const v4u*)(KR + idx_KR(b, key, 8 * c)); const int o = 32 + 4 * c;
                sc += bflo(qp[o]) * bflo(kv.x) + bfhi(qp[o]) * bfhi(kv.x) + bflo(qp[o + 1]) * bflo(kv.y) + bfhi(qp[o + 1]) * bfhi(kv.y)
                    + bflo(qp[o + 2]) * bflo(kv.z) + bfhi(qp[o + 2]) * bfhi(kv.z) + bflo(qp[o + 3]) * bflo(kv.w) + bfhi(qp[o + 3]) * bfhi(kv.w); }
            const float mn = fmaxf(m, sc), f = exp2f(m - mn), p = exp2f(sc - mn);
            lsum = lsum * f + p; m = mn;
            const size_t vcol = (size_t)perm16(b * SEQ + key);
#pragma unroll
            for (int d = 0; d < 64; ++d) acc[d] = acc[d] * f + p * bf2f(VT[(size_t)(h * 64 + d) * NTOK + vcol]);
        }
        const float il = 1.0f / lsum;
#pragma unroll
        for (int d = 0; d < 64; d += 2) *(unsigned*)(MIX + (size_t)(b * SEQ + s) * DM + h * 64 + d) = pk2(acc[d] * il, acc[d + 1] * il);
    }
    for (int idx = F.gtid; idx < NBATCH * BHD * SEQ; idx += GT) {
        const int s = idx & 4095, h = (idx >> 12) & 3, b = idx >> 14;
        unsigned qp[32];
#pragma unroll
        for (int i = 0; i < 8; ++i) { const v4u v = *(const v4u*)(SBQ + idx_SB(b, h, s, 8 * i)); qp[4 * i] = v.x; qp[4 * i + 1] = v.y; qp[4 * i + 2] = v.z; qp[4 * i + 3] = v.w; }
        float acc[64];
#pragma unroll
        for (int d = 0; d < 64; ++d) acc[d] = 0.f;
        float carry = 0.f;
        for (int key = s - 1; key >= 0; --key) {
            float z = 0.f;
#pragma unroll
            for (int c = 0; c < 8; ++c) { const v4u kv = *(const v4u*)(SBK + idx_SB(b, h, key, 8 * c));
                z += bflo(qp[4 * c]) * bflo(kv.x) + bfhi(qp[4 * c]) * bfhi(kv.x) + bflo(qp[4 * c + 1]) * bflo(kv.y) + bfhi(qp[4 * c + 1]) * bfhi(kv.y)
                   + bflo(qp[4 * c + 2]) * bflo(kv.z) + bfhi(qp[4 * c + 2]) * bfhi(kv.z) + bflo(qp[4 * c + 3]) * bflo(kv.w) + bfhi(qp[4 * c + 3]) * bfhi(kv.w); }
            const float sp = fmaxf(z, 0.f) + log2f(1.0f + exp2f(-fabsf(z)));
            const float a = exp2f(z - sp + carry);
            carry -= sp;
            const size_t vcol = (size_t)perm16(b * SEQ + key);
#pragma unroll
            for (int d = 0; d < 64; ++d) acc[d] += a * bf2f(SBVT[(size_t)(h * 64 + d) * NTOK + vcol]);
        }
#pragma unroll
        for (int d = 0; d < 64; d += 2) *(unsigned*)(MIX + (size_t)(b * SEQ + s) * DM + 512 + h * 64 + d) = pk2(acc[d], acc[d + 1]);
    }
    const float* pw = F.in[7] + (size_t)l * 4 * 64 * 64; const float* ps = F.in[8] + l * 256;
    for (int idx = F.gtid; idx < NTOK * 256; idx += GT) {
        const int t = idx >> 8, cc = idx & 255, g = cc >> 6, co = cc & 63, s = t & 4095, w = 2 << g;
        const int cnt = (s + 1) < w ? (s + 1) : w; const float ic = 1.0f / (float)cnt;
        float acc = 0.f;
        for (int c = 0; c < 64; ++c) {
            float sum = 0.f;
            for (int j = 0; j < cnt; ++j) sum += bf2f(U[(size_t)(t - j) * 256 + g * 64 + c]);
            const float d = sum * ic - bf2f(U[(size_t)t * 256 + g * 64 + c]);
            acc += d * pw[(g * 64 + c) * 64 + co];
        }
        MIX[(size_t)t * DM + 768 + cc] = (bf16)f2bf(acc * ps[cc]);
    }
}

__device__ __forceinline__ void phase_a4(const Frame& F, int l) {
    const bf16* MIX = PTR(bf16, F_MIX); const bf16* w = wl(F, l, WO_OUT); bf16* xb = PTR(bf16, F_XB);
    const float* xin = l == 0 ? F.in[0] : F.X;
    for (size_t idx = F.gtid; idx < (size_t)NTOK * DM; idx += GT) {
        const int t = (int)(idx >> 10), n = (int)(idx & 1023);
        const float v = xin[idx] + dot_bf16(MIX + (size_t)t * DM, w + (size_t)n * DM, DM);
        F.X[idx] = v; xb[idx] = (bf16)f2bf(v);
    }
}

__device__ __forceinline__ void phase_m1(const Frame& F, int l) {
    const float* wr = PTR(float, WS_WR) + (size_t)l * 40 * 1024; const float* bg = F.in[12] + l * 4; const float* be = F.in[14] + l * 32;
    float* R2 = SMALLP(float, SM_R2); int* RTE = SMALLP(int, SM_RTE); int* RTPOS = SMALLP(int, SM_RTPOS); float* RTC = SMALLP(float, SM_RTC);
    unsigned* cnt = F.ctl + CW_CNT + l * 32;
    for (int t = F.gw; t < NTOK; t += NGW) {
        float xv[16]; float ss = 0.f;
#pragma unroll
        for (int i = 0; i < 16; ++i) { xv[i] = F.X[(size_t)t * DM + F.lane + 64 * i]; ss += xv[i] * xv[i]; }
        ss = wave_sum(ss);
        const float r2 = 1.0f / sqrtf(ss * (1.0f / DM) + EPS);
        float l0 = 0.f, l1 = 0.f, l2 = 0.f, l3 = 0.f;
#pragma unroll 1
        for (int j = 0; j < 4; ++j) { const float* wp = wr + j * 1024 + F.lane; float p = 0.f;
#pragma unroll
            for (int i = 0; i < 16; ++i) p += xv[i] * wp[64 * i];
            const float v = wave_sum(p) * r2 + bg[j];
            l0 = j == 0 ? v : l0; l1 = j == 1 ? v : l1; l2 = j == 2 ? v : l2; l3 = j == 3 ? v : l3; }
        int g = 0; float gm = l0;
        if (l1 > gm) { gm = l1; g = 1; }
        if (l2 > gm) { gm = l2; g = 2; }
        if (l3 > gm) { gm = l3; g = 3; }
        const float psel = 1.0f / (expf(l0 - gm) + expf(l1 - gm) + expf(l2 - gm) + expf(l3 - gm));
        g = __builtin_amdgcn_readfirstlane(g);
        int i1 = 0, i2 = 0; float m1 = -INFINITY, m2 = -INFINITY;
#pragma unroll 1
        for (int e = 0; e < 8; ++e) { const float* wp = wr + (size_t)(4 + 8 * g + e) * 1024 + F.lane; float p = 0.f;
#pragma unroll
            for (int i = 0; i < 16; ++i) p += xv[i] * wp[64 * i];
            const float v = wave_sum(p) * r2 + be[8 * g + e];
            if (v > m1) { m2 = m1; i2 = i1; m1 = v; i1 = e; } else if (v > m2) { m2 = v; i2 = e; } }
        const float ex = expf(m2 - m1), w1 = 1.0f / (1.0f + ex), w2 = ex / (1.0f + ex);
        if (F.lane == 0) {
            const int e1 = g * 8 + i1, e2 = g * 8 + i2;
            const unsigned p1 = atomicAdd(cnt + e1, 1u), p2 = atomicAdd(cnt + e2, 1u);
            R2[t] = r2; RTE[2 * t] = e1; RTE[2 * t + 1] = e2; RTPOS[2 * t] = (int)p1; RTPOS[2 * t + 1] = (int)p2; RTC[2 * t] = psel * w1; RTC[2 * t + 1] = psel * w2;
        }
    }
}
__device__ __forceinline__ void moe_offsets(const Frame& F, int l) {
    LAS int* off = (LAS int*)F.lds; LAS int* cn = (LAS int*)(F.lds + 256);
    __syncthreads();
    if (F.tid == 0) { int a = 0; for (int e = 0; e < 32; ++e) { const int c = (int)__hip_atomic_load(F.ctl + CW_CNT + l * 32 + e, RLX_AGENT); off[e] = a; cn[e] = c; a += (c + 255) & ~255; } off[32] = a; }
    __syncthreads();
}
__device__ __forceinline__ int find_expert(LAS int* off, int r) { int e = 0; for (int j = 1; j < 32; ++j) if (r >= off[j]) e = j; return e; }

__device__ __forceinline__ void phase_m2(const Frame& F, int l) {
    moe_offsets(F, l);
    LAS int* off = (LAS int*)F.lds; LAS int* cn = (LAS int*)(F.lds + 256);
    const float* R2 = SMALLP(float, SM_R2); const int* RTE = SMALLP(int, SM_RTE); const int* RTPOS = SMALLP(int, SM_RTPOS); const float* RTC = SMALLP(float, SM_RTC);
    int* TROW = SMALLP(int, SM_TROW); float* ROWR2 = SMALLP(float, SM_ROWR2); float* ROWC = SMALLP(float, SM_ROWC); int* ROWTOK = SMALLP(int, SM_ROWTOK);
    for (int idx = F.gtid; idx < NTOK * 2; idx += GT) { const int t = idx >> 1, e = RTE[idx], row = off[e] + RTPOS[idx];
        ROWTOK[row] = t; ROWC[row] = RTC[idx]; ROWR2[row] = R2[t]; TROW[idx] = row; }
    const int rtot = off[32];
    for (int r = F.gtid; r < rtot; r += GT) { const int e = find_expert(off, r); if (r - off[e] >= cn[e]) { ROWTOK[r] = 0; ROWC[r] = 0.f; ROWR2[r] = 0.f; } }
}
__device__ __forceinline__ void phase_m3(const Frame& F, int l) {
    moe_offsets(F, l);
    LAS int* off = (LAS int*)F.lds; LAS int* cn = (LAS int*)(F.lds + 256);
    const bf16* xb = PTR(bf16, F_XB); const bf16* w = wl(F, l, WO_GU); bf16* H = PTR(bf16, F_H);
    const float* ROWR2 = SMALLP(float, SM_ROWR2); const float* ROWC = SMALLP(float, SM_ROWC); const int* ROWTOK = SMALLP(int, SM_ROWTOK);
    const int rtot = off[32];
    for (size_t idx = F.gtid; idx < (size_t)rtot * 256; idx += GT) {
        const int r = (int)(idx >> 8), f = (int)(idx & 255), e = find_expert(off, r);
        if (r - off[e] >= cn[e]) continue;
        const bf16* xr = xb + (size_t)ROWTOK[r] * DM; const bf16* wg = w + ((size_t)e * 512 + 256 * (f >> 7) + (f & 127)) * DM;
        const float r2 = ROWR2[r]; const float a = dot_bf16(xr, wg, DM) * r2, bb = dot_bf16(xr, wg + (size_t)128 * DM, DM) * r2;
        H[(size_t)r * 256 + f] = (bf16)f2bf(a / (1.0f + expf(-a)) * bb * ROWC[r]);
    }
}
__device__ __forceinline__ void phase_m4(const Frame& F, int l) {
    moe_offsets(F, l);
    LAS int* off = (LAS int*)F.lds; LAS int* cn = (LAS int*)(F.lds + 256);
    const bf16* H = PTR(bf16, F_H); const bf16* w = wl(F, l, WO_D); bf16* Y = PTR(bf16, F_Y);
    const int rtot = off[32];
    for (size_t idx = F.gtid; idx < (size_t)rtot * 1024; idx += GT) {
        const int r = (int)(idx >> 10), n = (int)(idx & 1023), e = find_expert(off, r);
        if (r - off[e] >= cn[e]) continue;
        Y[idx] = (bf16)f2bf(dot_bf16(H + (size_t)r * 256, w + ((size_t)e * 1024 + n) * 256, 256));
    }
}
__device__ __forceinline__ void phase_m5(const Frame& F, int l) {
    const bf16* Y = PTR(bf16, F_Y); const int* TROW = SMALLP(int, SM_TROW); bf16* xb = PTR(bf16, F_XB); float* rinv = SMALLP(float, SM_RINV);
    for (int t = F.gw; t < NTOK; t += NGW) {
        const int r0 = TROW[2 * t], r1 = TROW[2 * t + 1];
        float xv[16]; float ss = 0.f;
#pragma unroll
        for (int i = 0; i < 16; ++i) { const int c = F.lane + 64 * i; xv[i] = F.X[(size_t)t * DM + c] + bf2f(Y[(size_t)r0 * DM + c]) + bf2f(Y[(size_t)r1 * DM + c]); ss += xv[i] * xv[i]; }
        ss = wave_sum(ss);
        const float r = 1.0f / sqrtf(ss * (1.0f / DM) + EPS);
        if (l == DEPTH - 1) {
#pragma unroll
            for (int i = 0; i < 16; ++i) { const int c = F.lane + 64 * i; F.X[(size_t)t * DM + c] = xv[i] * r * F.in[18][c]; }
        } else {
#pragma unroll
            for (int i = 0; i < 16; ++i) { const int c = F.lane + 64 * i; F.X[(size_t)t * DM + c] = xv[i]; xb[(size_t)t * DM + c] = (bf16)f2bf(xv[i]); }
            if (F.lane == 0) rinv[t] = r;
        }
    }
}

constexpr int N_PHASES = 1 + 9 * DEPTH;
struct Args { const float* in[19]; float* out; unsigned char* ws; int ph_lo, ph_hi, li, pad; };
__global__ void __launch_bounds__(NTHREADS, 2) mk_fwd(Args args) {
    extern __shared__ __attribute__((aligned(16))) unsigned char lds[];
    Frame F;
    F.lds = (LAS unsigned char*)lds;
    F.tid = threadIdx.x; F.lane = F.tid & 63; F.wave = __builtin_amdgcn_readfirstlane(F.tid >> 6);
    F.gtid = blockIdx.x * NTHREADS + F.tid; F.gw = blockIdx.x * NWAVES + F.wave;
#pragma unroll
    for (int i = 0; i < 19; ++i) F.in[i] = args.in[i];
    F.X = args.out; F.ws = args.ws; F.ctl = (unsigned*)(args.ws + WS_CTL);
    volatile LAS unsigned* MISC = (volatile LAS unsigned*)(F.lds + MISC_OFF);
    if (F.tid < 32) MISC[F.tid] = 0u;
    __syncthreads();
    XcdBarrier bar; bar.bar = F.ctl + CW_BAR; bar.x = 0; bar.st = nullptr;
    if (MK_N_LAUNCHES == 1) bar = xcd_barrier_post(F.ctl + CW_BAR, MISC + 8);
    const Frame F0 = F;
    for (int ph = args.ph_lo; ph < args.ph_hi; ++ph) {
        F = F0;
        asm volatile("" : "+v"(F.tid), "+v"(F.lane), "+v"(F.gtid));
        asm volatile("" : "+s"(F.gw), "+s"(F.wave), "+s"(F.ws), "+s"(F.X), "+s"(F.ctl));
        if (ph == 0) phase_p0(F);
        else { const int l = (ph - 1) / 9, k = (ph - 1) % 9;
            switch (k) {
                case 0: phase_a1(F, l); break;
                case 1: phase_a2(F, l); break;
                case 2: phase_a3(F, l); break;
                case 3: phase_a4(F, l); break;
                case 4: phase_m1(F, l); break;
                case 5: phase_m2(F, l); break;
                case 6: phase_m3(F, l); break;
                case 7: phase_m4(F, l); break;
                default: phase_m5(F, l); break;
            } }
        if (ph + 1 < args.ph_hi) xcd_barrier(bar);
    }
}

extern "C" void kernel_launch(void* const* d_in, const int* in_sizes, int n_in, void* d_out, int out_size, void* d_ws, size_t ws_size, hipStream_t stream) {
    static int ok = 0;
    if (ok == 0) {
        ok = 1;
        if (n_in != 19 || out_size != NTOK * DM || ws_size < F_END) { fprintf(stderr, "kernel_launch: unexpected shapes (n_in %d out %d ws %zu need %zu)\n", n_in, out_size, ws_size, (size_t)F_END); ok = -1; }
        if (hipFuncSetAttribute((const void*)mk_fwd, hipFuncAttributeMaxDynamicSharedMemorySize, LDS_BYTES) != hipSuccess) { fprintf(stderr, "kernel_launch: hipFuncSetAttribute failed\n"); ok = -1; }
    }
    if (ok < 0) return;
    (void)hipMemsetAsync((char*)d_ws + WS_CTL, 0, CTL_ZERO_BYTES, stream);
    Args a{};
    for (int i = 0; i < 19; ++i) a.in[i] = (const float*)d_in[i];
    a.out = (float*)d_out; a.ws = (unsigned char*)d_ws;
    if (MK_N_LAUNCHES == 1) { a.ph_lo = 0; a.ph_hi = N_PHASES; a.li = 0; hipLaunchKernelGGL(mk_fwd, dim3(256), dim3(NTHREADS), LDS_BYTES, stream, a); }
    else for (int p = 0; p < N_PHASES; ++p) { a.ph_lo = p; a.ph_hi = p + 1; a.li = p; hipLaunchKernelGGL(mk_fwd, dim3(256), dim3(NTHREADS), LDS_BYTES, stream, a); }
}
```

```cpp
#include <hip/hip_runtime.h>
#include <cstdio>
#include <cstdint>

#ifndef MK_N_LAUNCHES
#define MK_N_LAUNCHES 1
#endif

#define GAS __attribute__((address_space(1)))
#define LAS __attribute__((address_space(3)))
typedef unsigned short bf16;
typedef unsigned v4u __attribute__((ext_vector_type(4)));
typedef float f32x4 __attribute__((ext_vector_type(4)));
typedef GAS unsigned gu32;
#define RLX_AGENT __ATOMIC_RELAXED, __HIP_MEMORY_SCOPE_AGENT
#define LDS_WAIT() asm volatile("s_waitcnt lgkmcnt(0)" ::: "memory")

constexpr int DM = 1024, NBATCH = 4, SEQ = 4096, NTOK = NBATCH * SEQ, DEPTH = 2;
constexpr int AH = 8, AQL = 256, AKVL = 128;
constexpr int BHD = 4;
constexpr int DIN = 1440, NPAD = 1536;
constexpr int NEXP = 32, DE = 256;
constexpr float EPS = 1e-6f;
constexpr float LOG2E = 1.4426950408889634f;
constexpr float QSCALE_A = 0.10206207261596575f * LOG2E;
constexpr float QSCALE_B = 0.125f * LOG2E;
constexpr int NWAVES = 8, NTHREADS = 512;
constexpr int RMAX = 40960;

constexpr size_t MiB = 1u << 20;
constexpr size_t WS_CTL = 0, CTL_ZERO_BYTES = 256 * 1024;
constexpr size_t WS_ROPE = 512 * 1024;
constexpr size_t WS_WR = 1 * MiB;
constexpr size_t WO_IN = 0, WO_UQ = 1572864, WO_UKV = WO_UQ + 196608, WO_OUT = WO_UKV + 262144, WO_GU = WO_OUT + 1048576, WO_D = WO_GU + 16777216, WO_END = WO_D + 8388608;
constexpr size_t WL_BYTES = WO_END * 2;
constexpr size_t P_W = 2 * MiB;
constexpr size_t SM_RINV = 0, SM_R2 = 65536, SM_RTE = 131072, SM_RTPOS = 262144, SM_RTC = 393216, SM_TROW = 524288, SM_SSQQ = 655360, SM_SSQKV = 917504,
                 SM_ROWR2 = 1179648, SM_ROWC = 1343488, SM_ROWTOK = 1507328, SM_END = 1671168;
static_assert(SM_END <= 2 * MiB, "small");
constexpr size_t F_XB = 110 * MiB, F_SMALL = 142 * MiB, F_KR = 144 * MiB, F_U = 145 * MiB, F_SBQ = 153 * MiB, F_SBK = 161 * MiB, F_SBVT = 169 * MiB,
                 F_Q = 177 * MiB, F_KN = 201 * MiB, F_VT = 217 * MiB, F_CQ = 233 * MiB, F_CKVX = 241 * MiB, F_MIX = 233 * MiB, F_END = 265 * MiB;
constexpr size_t F_H = 144 * MiB, F_Y = 164 * MiB;
static_assert(F_Y + (size_t)RMAX * 1024 * 2 <= F_END, "moe overlay");
static_assert(P_W + 2 * WL_BYTES <= F_XB, "weights fit");

constexpr int CW_BAR = 1024;
constexpr int CW_CNT = 8192;

constexpr int LDS_BYTES = 147456;
constexpr int MISC_OFF = 131072 + 320;

__device__ __forceinline__ float bf2f(bf16 v) { return __uint_as_float(((unsigned)v) << 16); }
__device__ __forceinline__ float bflo(unsigned w) { return __uint_as_float(w << 16); }
__device__ __forceinline__ float bfhi(unsigned w) { return __uint_as_float(w & 0xffff0000u); }
__device__ __forceinline__ unsigned f2bf(float f) { unsigned u = __float_as_uint(f); return (u + 0x7fffu + ((u >> 16) & 1u)) >> 16; }
__device__ __forceinline__ unsigned pk2(float lo, float hi) { return f2bf(lo) | (f2bf(hi) << 16); }
__device__ __forceinline__ float wave_sum(float v) {
#pragma unroll
    for (int o = 1; o < 64; o <<= 1) v += __shfl_xor(v, o);
    return v;
}
__device__ __forceinline__ int perm16(int t) { return (t & ~15) | (t & 3) | ((t & 8) >> 1) | ((t & 4) << 1); }
__device__ __forceinline__ size_t idx_KR(int b, int s, int i) { return ((((size_t)b * 64 + (s >> 6)) * 4 + (i >> 3)) * 64 + (s & 63)) * 8 + (i & 7); }
__device__ __forceinline__ size_t idx_KN(int b, int h, int s, int d) { return (((((size_t)b * 8 + h) * 64 + (s >> 6)) * 8 + (d >> 3)) * 64 + (s & 63)) * 8 + (d & 7); }
__device__ __forceinline__ size_t idx_Q(int b, int h, int s, int d) { return (((size_t)b * 8 + h) * SEQ + s) * 96 + d; }
__device__ __forceinline__ size_t idx_SB(int b, int h, int s, int d) { return (((size_t)b * 4 + h) * SEQ + s) * 64 + d; }

__device__ __forceinline__ float dot_bf16(const bf16* a, const bf16* b, int n) {
    float acc = 0.f;
    for (int k = 0; k < n; k += 8) {
        const v4u x = *(const v4u*)(a + k), y = *(const v4u*)(b + k);
        acc += bflo(x.x) * bflo(y.x) + bfhi(x.x) * bfhi(y.x) + bflo(x.y) * bflo(y.y) + bfhi(x.y) * bfhi(y.y)
             + bflo(x.z) * bflo(y.z) + bfhi(x.z) * bfhi(y.z) + bflo(x.w) * bflo(y.w) + bfhi(x.w) * bfhi(y.w);
    }
    return acc;
}

#define XB_TMO      128
#define XB_XCNT(j)  (256  + 64 * (j))
#define XB_XSUB(j)  (1280 + 64 * (j))
#define XB_XGEN(j)  (2304 + 64 * (j))
#define XB_TOP      3328
#define XB_TOPGEN   3392
#define XCD_BAR_WORDS 3456
#define XB_SPIN_CAP (1u << 22)
__device__ __forceinline__ unsigned xb_ld(unsigned* p)              { return __hip_atomic_load(p, __ATOMIC_RELAXED, __HIP_MEMORY_SCOPE_AGENT); }
__device__ __forceinline__ unsigned xb_add(unsigned* p, unsigned v) { return __hip_atomic_fetch_add(p, v, __ATOMIC_RELAXED, __HIP_MEMORY_SCOPE_AGENT); }
__device__ __forceinline__ unsigned xb_xcc_id() { return (unsigned)__builtin_amdgcn_s_getreg((3 << 11) | 20) & 0xFu; }
#define XB_SPIN(cond, bar) do { unsigned _sp = 0; while (cond) { __builtin_amdgcn_s_sleep(1); \
    if ((++_sp & 255u) == 0u) { if (xb_ld(&(bar)[XB_TMO])) break; if (_sp > XB_SPIN_CAP) { atomicAdd(&(bar)[XB_TMO], 1u); break; } } } } while (0)
struct XcdBarrier { unsigned* bar; unsigned x; volatile LAS unsigned* st; };
__device__ __forceinline__ XcdBarrier xcd_barrier_post(unsigned* bar, volatile LAS unsigned* st) {
    XcdBarrier b; b.bar = bar; b.x = xb_xcc_id(); b.st = st;
    if (threadIdx.x == 0) (void)xb_add(&bar[XB_XCNT(b.x)], 1u);
    return b;
}
__device__ __forceinline__ void xcd_barrier_complete(unsigned* bar, unsigned x, unsigned& nloc, unsigned& nx) {
    const unsigned G = gridDim.x * gridDim.y * gridDim.z;
    unsigned sum, cnt, mine, sp = 0u;
    for (;;) {
        sum = 0u; cnt = 0u; mine = 0u;
#pragma unroll
        for (unsigned j = 0; j < 16; ++j) { const unsigned c = xb_ld(&bar[XB_XCNT(j)]); sum += c; cnt += (c > 0u) ? 1u : 0u; mine = (j == x) ? c : mine; }
        if (sum == G) break;
        __builtin_amdgcn_s_sleep(1);
        if ((++sp & 255u) == 0u) { if (xb_ld(&bar[XB_TMO])) break; if (sp > XB_SPIN_CAP) { atomicAdd(&bar[XB_TMO], 1u); break; } }
    }
    nloc = mine > 0u ? mine : 1u; nx = cnt > 0u ? cnt : 1u;
}
__device__ __forceinline__ void xcd_barrier(const XcdBarrier& b) {
    asm volatile("s_waitcnt vmcnt(0)" ::: "memory");
    __syncthreads();
    if (threadIdx.x == 0) {
        unsigned* bar = b.bar;
        __builtin_amdgcn_s_waitcnt(0);
        unsigned nloc = b.st[0], nx = b.st[1];
        if (nloc == 0u) { xcd_barrier_complete(bar, b.x, nloc, nx); b.st[0] = nloc; b.st[1] = nx; }
        const unsigned old = xb_add(&bar[XB_XSUB(b.x)], 1u);
        const unsigned gen = old / nloc;
        if (old + 1u == (gen + 1u) * nloc) {
            __builtin_amdgcn_fence(__ATOMIC_RELEASE, "agent");
            asm volatile("s_waitcnt vmcnt(0)" ::: "memory");
            const unsigned og = xb_add(&bar[XB_TOP], 1u);
            const unsigned tg = og / nx;
            if (og + 1u == (tg + 1u) * nx) xb_add(&bar[XB_TOPGEN], 1u);
            else XB_SPIN(xb_ld(&bar[XB_TOPGEN]) == tg, bar);
            __builtin_amdgcn_fence(__ATOMIC_ACQUIRE, "agent");
            xb_add(&bar[XB_XGEN(b.x)], 1u);
            asm volatile("s_waitcnt vmcnt(0)" ::: "memory");
        } else {
            XB_SPIN(xb_ld(&bar[XB_XGEN(b.x)]) == gen, bar);
            __builtin_amdgcn_fence(__ATOMIC_ACQUIRE, "agent");
            asm volatile("s_waitcnt vmcnt(0)" ::: "memory");
        }
    }
    __syncthreads();
}


namespace pg8 {
typedef unsigned short bf16_t;
typedef short bf16x8 __attribute__((ext_vector_type(8)));
typedef unsigned u32x4 __attribute__((ext_vector_type(4)));
typedef unsigned u32x2 __attribute__((ext_vector_type(2)));
constexpr int BM = 256, BK = 64, HALF = 128, HTB = HALF * BK * 2, STAGE_BYTES = 8 * HTB, NXCD = 8, WGM = 8;
__host__ __device__ __forceinline__ int lds_byte(int r, int c) { const int st = (r >> 4) * 2 + (c >> 5), rr = r & 15, cc = c & 31, ob = rr * 64 + cc * 2; return st * 1024 + (ob ^ (((ob >> 9) & 1) << 5)); }
__host__ __device__ __forceinline__ void stage_rc(int b, int& R, int& C) { const int st = b / 1024, sb = b % 1024, swz = sb ^ (((sb >> 9) & 1) << 5); R = (st >> 1) * 16 + swz / 64; C = (st & 1) * 32 + (swz % 64) / 2; }
__host__ __device__ __forceinline__ int perm32(int rho) { const int n = rho >> 4, i = rho & 15; return 8 * (i >> 2) + 4 * n + (i & 3); }
struct Unit { int pm, pn; };
struct Gemm { const bf16_t* A; const bf16_t* Bt; int M, N, K; };
struct StaticOrder {
    int nM, nN, nwg, G, c;
    __device__ void init(int M, int N, int G_, int c_) { nM = M / BM; nN = N / BM; nwg = nM * nN; G = G_; c = c_; }
    __device__ bool next(int i, Unit& u) const {
        const long L = (long)i * G + c; if (L >= nwg) return false;
        int wgid = (int)L; { const int q = nwg / NXCD, r = nwg % NXCD, xcd = wgid % NXCD, off = wgid / NXCD; wgid = (xcd < r ? xcd * (q + 1) : r * (q + 1) + (xcd - r) * q) + off; }
        const int nig = WGM * nN, gid = wgid / nig, fm = gid * WGM, gsz = (nM - fm) < WGM ? (nM - fm) : WGM;
        u.pm = fm + ((wgid % nig) % gsz); u.pn = (wgid % nig) / gsz; return true;
    }
};
struct MoeOrder {
    int ntiles, npn, G, c; const LAS int* tile_e;
    __device__ bool next(int i, Unit& u) const {
        const int L = i * G + c; if (L >= ntiles * npn) return false;
        const int tile = L / npn, pnl = L % npn; u.pm = tile; u.pn = tile_e[tile] * npn + pnl; return true;
    }
};
__device__ __forceinline__ unsigned cvt_pk_bf16(float lo, float hi) { unsigned r; asm volatile("v_cvt_pk_bf16_f32 %0, %1, %2" : "=v"(r) : "v"(lo), "v"(hi)); return r; }
__device__ __forceinline__ u32x4 pack8(const f32x4 a, const f32x4 b) { u32x4 w; w.x = cvt_pk_bf16(a[0], a[1]); w.y = cvt_pk_bf16(a[2], a[3]); w.z = cvt_pk_bf16(b[0], b[1]); w.w = cvt_pk_bf16(b[2], b[3]); return w; }
__device__ __forceinline__ u32x2 pack4(const f32x4 a) { u32x2 w; w.x = cvt_pk_bf16(a[0], a[1]); w.y = cvt_pk_bf16(a[2], a[3]); return w; }

template <class Epi, class Sched, bool ALIGN_EPI, bool GATHER>
__device__ __forceinline__ void gemm_phase(LAS unsigned char* lds, const Gemm g, const Sched& S, const Epi& E, const int* rowtok) {
    const int tid = threadIdx.x, wid = __builtin_amdgcn_readfirstlane(tid >> 6), lane = tid & 63, wr = wid >> 2, wc = wid & 3, fr = lane & 15, fq = lane >> 4;
    const int K = g.K, nt = K / BK;
    const size_t kstep = (size_t)(BK * 2);
    const size_t hstep = (size_t)HALF * K * 2;
    const size_t tstep = 2 * hstep;
    int RA[2], CA[2]; unsigned voffB[2], voffA[2], cv0[2], cv1[2], nv0[2], nv1[2];
#pragma unroll
    for (int i = 0; i < 2; ++i) { int R, C; stage_rc(tid * 16 + i * 8192, R, C); const int Rb = (R & ~31) + perm32(R & 31);
        RA[i] = R; CA[i] = C; voffB[i] = (unsigned)(Rb * K + C) * 2u; voffA[i] = (unsigned)(R * K + C) * 2u; cv0[i] = 0u; cv1[i] = 0u; nv0[i] = 0u; nv1[i] = 0u; }
    const unsigned ldsw = (unsigned)wid * 1024u;
    const int aoff = lds_byte(wr * 64 + fr, fq * 8), boff = lds_byte(wc * 32 + fr, fq * 8);
#define PG8_SA(b, h) (((b) * 2 + (h)) * HTB)
#define PG8_SB(b, h) ((4 + (b) * 2 + (h)) * HTB)
#define PG8_STAGE(bufoff, gbase, voff) do { _Pragma("unroll") for (int _i = 0; _i < 2; ++_i) \
        __builtin_amdgcn_global_load_lds((const unsigned*)((const char*)(gbase) + (voff)[_i]), (LAS unsigned*)(lds + (bufoff) + ldsw + _i * 8192), 16, 0, 0); } while (0)
#define PG8_STAGE_A(bufoff, gbase, half, V0, V1) do { if constexpr (GATHER) { if (half) PG8_STAGE(bufoff, gbase, V1); else PG8_STAGE(bufoff, gbase, V0); } \
        else { PG8_STAGE(bufoff, (gbase) + (half) * hstep, voffA); } } while (0)
#define PG8_LDA(dst, b, h) do { _Pragma("unroll") for (int m = 0; m < 4; ++m) _Pragma("unroll") for (int k = 0; k < 2; ++k) dst[m][k] = *(const LAS bf16x8*)(lds + PG8_SA(b, h) + aoff + m * 2048 + k * 1024); } while (0)
#define PG8_LDB(dst, b, h) do { _Pragma("unroll") for (int n = 0; n < 2; ++n) _Pragma("unroll") for (int k = 0; k < 2; ++k) dst[n][k] = *(const LAS bf16x8*)(lds + PG8_SB(b, h) + boff + n * 2048 + k * 1024); } while (0)
#define PG8_MMA(ai, bj, At, Bt) do { __builtin_amdgcn_s_setprio(1); _Pragma("unroll") for (int m = 0; m < 4; ++m) _Pragma("unroll") for (int n = 0; n < 2; ++n) _Pragma("unroll") for (int k = 0; k < 2; ++k) \
        acc[ai][bj][m][n] = __builtin_amdgcn_mfma_f32_16x16x32_bf16(Bt[n][k], At[m][k], acc[ai][bj][m][n], 0, 0, 0); __builtin_amdgcn_s_setprio(0); } while (0)
#define PG8_WAIT_V(n) asm volatile("s_waitcnt vmcnt(" #n ")" ::: "memory")
#define PG8_WAIT_L(n) asm volatile("s_waitcnt lgkmcnt(" #n ")" ::: "memory")
#define PG8_BAR __builtin_amdgcn_s_barrier()
#define PG8_SCHED __builtin_amdgcn_sched_barrier(0)
#define PG8_GVOFF(U, V0, V1) do { if constexpr (GATHER) { _Pragma("unroll") for (int _i = 0; _i < 2; ++_i) { \
        const unsigned t0_ = (unsigned)rowtok[(U).pm * BM + RA[_i]], t1_ = (unsigned)rowtok[(U).pm * BM + HALF + RA[_i]]; \
        V0[_i] = (t0_ * (unsigned)K + (unsigned)CA[_i]) * 2u; V1[_i] = (t1_ * (unsigned)K + (unsigned)CA[_i]) * 2u; } \
        asm volatile("s_waitcnt vmcnt(0)" ::: "memory"); } } while (0)
    Unit cur, nxt; int ui = 0;
    if (!S.next(0, cur)) return;
    f32x4 acc[2][2][4][2];
#pragma unroll
    for (int a = 0; a < 2; ++a)
#pragma unroll
        for (int b = 0; b < 2; ++b)
#pragma unroll
            for (int m = 0; m < 4; ++m)
#pragma unroll
                for (int n = 0; n < 2; ++n) acc[a][b][m][n] = (f32x4){0.f, 0.f, 0.f, 0.f};
    bf16x8 At[4][2], B0[2][2], B1[2][2];
    const char* cA = GATHER ? (const char*)g.A : (const char*)g.A + (size_t)cur.pm * tstep; const char* cB = (const char*)g.Bt + (size_t)cur.pn * tstep;
    PG8_GVOFF(cur, cv0, cv1);
    PG8_STAGE(PG8_SB(0, 0), cB, voffB); PG8_STAGE(PG8_SB(0, 1), cB + hstep, voffB); PG8_STAGE_A(PG8_SA(0, 0), cA, 0, cv0, cv1); PG8_STAGE_A(PG8_SA(0, 1), cA, 1, cv0, cv1);
    if (wr == 1) PG8_BAR;
    PG8_WAIT_V(2); PG8_BAR;
    PG8_STAGE(PG8_SB(1, 0), cB + kstep, voffB); PG8_STAGE_A(PG8_SA(1, 0), cA + kstep, 0, cv0, cv1); PG8_STAGE(PG8_SB(1, 1), cB + hstep + kstep, voffB);
    PG8_WAIT_V(6); PG8_BAR;
    for (;;) {
        const bool has_next = S.next(ui + 1, nxt);
        const char* nA = GATHER ? (const char*)g.A : (has_next ? (const char*)g.A + (size_t)nxt.pm * tstep : cA); const char* nB = has_next ? (const char*)g.Bt + (size_t)nxt.pn * tstep : cB;
        if constexpr (GATHER) { if (has_next) { PG8_GVOFF(nxt, nv0, nv1); } else { nv0[0] = cv0[0]; nv0[1] = cv0[1]; nv1[0] = cv1[0]; nv1[1] = cv1[1]; } }
#pragma unroll 1
        for (int t = 0; t < nt; t += 2) {
            const bool last = (t == nt - 2);
            const char* a1 = cA + (size_t)(t + 1) * kstep;
            const char* a2 = last ? nA : cA + (size_t)(t + 2) * kstep; const char* b2 = last ? nB : cB + (size_t)(t + 2) * kstep;
            const char* a3 = a2 + kstep; const char* b3 = b2 + kstep;
            unsigned va0[2] = {0u, 0u}, va1[2] = {0u, 0u};
            if constexpr (GATHER) { va0[0] = last ? nv0[0] : cv0[0]; va0[1] = last ? nv0[1] : cv0[1]; va1[0] = last ? nv1[0] : cv1[0]; va1[1] = last ? nv1[1] : cv1[1]; }
            PG8_LDB(B0, 0, 0); PG8_LDB(B1, 0, 1); PG8_SCHED; PG8_LDA(At, 0, 0); PG8_STAGE_A(PG8_SA(1, 1), a1, 1, cv0, cv1);
            PG8_WAIT_V(8); PG8_WAIT_L(0); PG8_BAR; PG8_MMA(0, 0, At, B0); PG8_MMA(0, 1, At, B1); PG8_BAR; PG8_SCHED;
            PG8_LDA(At, 0, 1); PG8_STAGE(PG8_SB(0, 0), b2, voffB); PG8_STAGE(PG8_SB(0, 1), b2 + hstep, voffB); PG8_STAGE_A(PG8_SA(0, 0), a2, 0, va0, va1);
            PG8_WAIT_V(8); PG8_WAIT_L(0); PG8_BAR; PG8_MMA(1, 0, At, B0); PG8_MMA(1, 1, At, B1); PG8_BAR; PG8_SCHED;
            PG8_LDB(B0, 1, 0); PG8_LDB(B1, 1, 1); PG8_SCHED; PG8_LDA(At, 1, 0); PG8_STAGE_A(PG8_SA(0, 1), a2, 1, va0, va1);
            PG8_WAIT_V(8); PG8_WAIT_L(0); PG8_BAR; PG8_MMA(0, 0, At, B0); PG8_MMA(0, 1, At, B1); PG8_BAR; PG8_SCHED;
            PG8_LDA(At, 1, 1); PG8_STAGE(PG8_SB(1, 0), b3, voffB); PG8_STAGE(PG8_SB(1, 1), b3 + hstep, voffB); PG8_STAGE_A(PG8_SA(1, 0), a3, 0, va0, va1);
            PG8_WAIT_V(8); PG8_WAIT_L(0); PG8_BAR; PG8_MMA(1, 0, At, B0); PG8_MMA(1, 1, At, B1); PG8_BAR; PG8_SCHED;
        }
        if constexpr (ALIGN_EPI) { if (wr == 0) PG8_BAR; }
        E(acc, cur, wr, wc, fr, fq);
        if (!has_next) break;
#pragma unroll
        for (int a = 0; a < 2; ++a)
#pragma unroll
            for (int b = 0; b < 2; ++b)
#pragma unroll
                for (int m = 0; m < 4; ++m)
#pragma unroll
                    for (int n = 0; n < 2; ++n) acc[a][b][m][n] = (f32x4){0.f, 0.f, 0.f, 0.f};
        cur = nxt; cA = nA; cB = nB; ++ui;
        if constexpr (GATHER) { cv0[0] = nv0[0]; cv0[1] = nv0[1]; cv1[0] = nv1[0]; cv1[1] = nv1[1]; }
        if constexpr (ALIGN_EPI) { if (wr == 1) PG8_BAR; }
    }
    PG8_WAIT_V(0);
    if constexpr (!ALIGN_EPI) { if (wr == 0) PG8_BAR; }
    PG8_BAR;
#undef PG8_SA
#undef PG8_SB
#undef PG8_STAGE
#undef PG8_STAGE_A
#undef PG8_LDA
#undef PG8_LDB
#undef PG8_MMA
#undef PG8_WAIT_V
#undef PG8_WAIT_L
#undef PG8_BAR
#undef PG8_SCHED
#undef PG8_GVOFF
}

typedef f32x4 Acc[2][2][4][2];
#define EPI_ROWS(u) const int rowb_ = (u).pm * BM + wr * 64 + fr
struct EpiA1 {
    const float* rinv; const float* rope; bf16_t *CQ, *CKVX, *KR, *U, *SBQ, *SBK; float *SSQQ, *SSQKV;
    __device__ __forceinline__ void operator()(const Acc& acc, const Unit& u, int wr, int wc, int fr, int fq) const {
        EPI_ROWS(u); const int pn = u.pn;
#pragma unroll
        for (int ai = 0; ai < 2; ++ai)
#pragma unroll
            for (int m = 0; m < 4; ++m) {
                const int row = rowb_ + ai * HALF + m * 16; const float r = rinv[row]; const int b = row >> 12, s = row & 4095;
                float ssq = 0.f;
#pragma unroll
                for (int bj = 0; bj < 2; ++bj) {
                    const f32x4 v0 = acc[ai][bj][m][0] * r, v1 = acc[ai][bj][m][1] * r; const int col = bj * HALF + wc * 32 + 8 * fq;
                    if (pn <= 1) {
                        bf16_t* dst = (pn == 0 ? CQ : CKVX) + (size_t)row * 256 + col; *(u32x4*)dst = pack8(v0, v1);
                        if (pn == 0 || bj == 0) ssq += (v0[0] * v0[0] + v0[1] * v0[1]) + (v0[2] * v0[2] + v0[3] * v0[3]) + (v1[0] * v1[0] + v1[1] * v1[1]) + (v1[2] * v1[2] + v1[3] * v1[3]);
                        if (pn == 1 && bj == 1 && wc == 0) {
                            const f32x4 t0 = *(const f32x4*)(rope + (size_t)(s * 16 + 4 * fq) * 2), t1 = *(const f32x4*)(rope + (size_t)(s * 16 + 4 * fq) * 2 + 4);
                            const f32x4 cs = {t0[0], t0[2], t1[0], t1[2]}, sn = {t0[1], t0[3], t1[1], t1[3]};
                            const f32x4 o1 = v0 * cs - v1 * sn, o2 = v1 * cs + v0 * sn;
                            *(u32x2*)(KR + idx_KR(b, s, 4 * fq)) = pack4(o1); *(u32x2*)(KR + idx_KR(b, s, 16 + 4 * fq)) = pack4(o2); }
                    } else if (pn <= 3) {
                        const float sc = pn == 2 ? QSCALE_B : 1.0f;
                        *(u32x4*)((pn == 2 ? SBQ : SBK) + idx_SB(b, 2 * bj + (wc >> 1), s, 32 * (wc & 1) + 8 * fq)) = pack8(v0 * sc, v1 * sc);
                    } else { *(u32x4*)(U + (size_t)row * 256 + col) = pack8(v0, v1); }
                }
                if (pn <= 1) { ssq += __shfl_xor(ssq, 16); ssq += __shfl_xor(ssq, 32); if (fq == 0) (pn == 0 ? SSQQ : SSQKV)[row * 4 + wc] = ssq; }
                asm volatile("" ::: "memory");
            }
    }
};
struct EpiVT {
    bf16_t* VT; const float* sc; int mode;
    __device__ __forceinline__ void operator()(const Acc& acc, const Unit& u, int wr, int wc, int fr, int fq) const {
        EPI_ROWS(u);
#pragma unroll
        for (int bj = 0; bj < 2; ++bj) {
            const int t0 = u.pn * BM + bj * HALF + wc * 32 + 8 * fq; f32x4 s0, s1;
            if (mode == 0) { s0 = *(const f32x4*)(sc + t0); s1 = *(const f32x4*)(sc + t0 + 4); }
            else {
#pragma unroll
                for (int e = 0; e < 4; ++e) { const f32x4 p = *(const f32x4*)(sc + (size_t)(t0 + e) * 4), q = *(const f32x4*)(sc + (size_t)(t0 + 4 + e) * 4);
                    s0[e] = 1.0f / sqrtf(((p[0] + p[1]) + (p[2] + p[3])) * (1.0f / AKVL) + EPS); s1[e] = 1.0f / sqrtf(((q[0] + q[1]) + (q[2] + q[3])) * (1.0f / AKVL) + EPS); } }
            const int base16 = t0 & ~15, p0 = base16 + ((t0 & 8) ? 4 : 0), p1 = base16 + ((t0 & 8) ? 12 : 8);
#pragma unroll
            for (int ai = 0; ai < 2; ++ai)
#pragma unroll
                for (int m = 0; m < 4; ++m) { const int f = rowb_ + ai * HALF + m * 16;
                    *(u32x2*)(VT + (size_t)f * NTOK + p0) = pack4(acc[ai][bj][m][0] * s0); *(u32x2*)(VT + (size_t)f * NTOK + p1) = pack4(acc[ai][bj][m][1] * s1); }
        }
    }
};
struct EpiQ {
    const float* ssq; const float* rope; bf16_t* Q;
    __device__ __forceinline__ void operator()(const Acc& acc, const Unit& u, int wr, int wc, int fr, int fq) const {
        EPI_ROWS(u); const int pn = u.pn;
#pragma unroll
        for (int ai = 0; ai < 2; ++ai)
#pragma unroll
            for (int m = 0; m < 4; ++m) {
                const int row = rowb_ + ai * HALF + m * 16; const int b = row >> 12, s = row & 4095;
                const f32x4 p = *(const f32x4*)(ssq + (size_t)row * 4);
                const float r = QSCALE_A / sqrtf(((p[0] + p[1]) + (p[2] + p[3])) * (1.0f / AQL) + EPS);
#pragma unroll
                for (int bj = 0; bj < 2; ++bj) {
                    const f32x4 v0 = acc[ai][bj][m][0] * r, v1 = acc[ai][bj][m][1] * r;
                    if (pn < 2) { *(u32x4*)(Q + idx_Q(b, 4 * pn + 2 * bj + (wc >> 1), s, 32 * (wc & 1) + 8 * fq)) = pack8(v0, v1); }
                    else { const f32x4 t0 = *(const f32x4*)(rope + (size_t)(s * 16 + 4 * fq) * 2), t1 = *(const f32x4*)(rope + (size_t)(s * 16 + 4 * fq) * 2 + 4);
                        const f32x4 cs = {t0[0], t0[2], t1[0], t1[2]}, sn = {t0[1], t0[3], t1[1], t1[3]};
                        const f32x4 o1 = v0 * cs - v1 * sn, o2 = v1 * cs + v0 * sn; const int h = 4 * bj + wc;
                        *(u32x2*)(Q + idx_Q(b, h, s, 64 + 4 * fq)) = pack4(o1); *(u32x2*)(Q + idx_Q(b, h, s, 80 + 4 * fq)) = pack4(o2); }
                }
            }
    }
};
struct EpiKN {
    const float* ssq; bf16_t* KN;
    __device__ __forceinline__ void operator()(const Acc& acc, const Unit& u, int wr, int wc, int fr, int fq) const {
        EPI_ROWS(u); const int pn = u.pn;
#pragma unroll
        for (int ai = 0; ai < 2; ++ai)
#pragma unroll
            for (int m = 0; m < 4; ++m) {
                const int row = rowb_ + ai * HALF + m * 16; const int b = row >> 12, s = row & 4095;
                const f32x4 p = *(const f32x4*)(ssq + (size_t)row * 4);
                const float r = 1.0f / sqrtf(((p[0] + p[1]) + (p[2] + p[3])) * (1.0f / AKVL) + EPS);
#pragma unroll
                for (int bj = 0; bj < 2; ++bj)
                    *(u32x4*)(KN + idx_KN(b, 4 * pn + 2 * bj + (wc >> 1), s, 32 * (wc & 1) + 8 * fq)) = pack8(acc[ai][bj][m][0] * r, acc[ai][bj][m][1] * r);
            }
    }
};
struct EpiOut {
    const float* xin; float* X; bf16_t* XB;
    __device__ __forceinline__ void operator()(const Acc& acc, const Unit& u, int wr, int wc, int fr, int fq) const {
        EPI_ROWS(u);
#pragma unroll
        for (int ai = 0; ai < 2; ++ai)
#pragma unroll
            for (int m = 0; m < 4; ++m) {
                const int row = rowb_ + ai * HALF + m * 16;
#pragma unroll
                for (int bj = 0; bj < 2; ++bj) { const size_t o = (size_t)row * DM + u.pn * BM + bj * HALF + wc * 32 + 8 * fq;
                    const f32x4 v0 = *(const f32x4*)(xin + o) + acc[ai][bj][m][0], v1 = *(const f32x4*)(xin + o + 4) + acc[ai][bj][m][1];
                    *(f32x4*)(X + o) = v0; *(f32x4*)(X + o + 4) = v1; *(u32x4*)(XB + o) = pack8(v0, v1); }
            }
    }
};
struct EpiGU {
    const float* rowr2; const float* rowc; bf16_t* H;
    __device__ __forceinline__ void operator()(const Acc& acc, const Unit& u, int wr, int wc, int fr, int fq) const {
        EPI_ROWS(u); const int pnl = u.pn & 1;
#pragma unroll
        for (int ai = 0; ai < 2; ++ai)
#pragma unroll
            for (int m = 0; m < 4; ++m) {
                const int row = rowb_ + ai * HALF + m * 16; const float r2 = rowr2[row], c = rowc[row];
                f32x4 h[2];
#pragma unroll
                for (int n = 0; n < 2; ++n)
#pragma unroll
                    for (int e = 0; e < 4; ++e) { const float gt = acc[ai][0][m][n][e] * r2, up = acc[ai][1][m][n][e] * r2;
                        h[n][e] = gt * __builtin_amdgcn_rcpf(1.0f + __builtin_amdgcn_exp2f(-gt * LOG2E)) * up * c; }
                *(u32x4*)(H + (size_t)row * 256 + pnl * 128 + wc * 32 + 8 * fq) = pack8(h[0], h[1]);
            }
    }
};
struct EpiY {
    bf16_t* Y;
    __device__ __forceinline__ void operator()(const Acc& acc, const Unit& u, int wr, int wc, int fr, int fq) const {
        EPI_ROWS(u); const int pnl = u.pn & 3;
#pragma unroll
        for (int ai = 0; ai < 2; ++ai)
#pragma unroll
            for (int m = 0; m < 4; ++m) {
                const int row = rowb_ + ai * HALF + m * 16;
#pragma unroll
                for (int bj = 0; bj < 2; ++bj) *(u32x4*)(Y + (size_t)row * DM + pnl * BM + bj * HALF + wc * 32 + 8 * fq) = pack8(acc[ai][bj][m][0], acc[ai][bj][m][1]);
            }
    }
};
}

struct Frame {
    LAS unsigned char* lds;
    unsigned* ctl;
    int tid, lane, wave, gtid, gw, bid;
    float* X;
    unsigned char* ws;
};
constexpr int GT = 256 * NTHREADS, NGW = 256 * NWAVES;
constexpr int PARAM_OFF = 131072 + 512;
__device__ __forceinline__ const float* inp(const Frame& F, int k) {
    const unsigned long long v = ((const LAS unsigned long long*)(F.lds + PARAM_OFF))[k];
    const unsigned lo = __builtin_amdgcn_readfirstlane((unsigned)v), hi = __builtin_amdgcn_readfirstlane((unsigned)(v >> 32));
    return (const float*)(((unsigned long long)hi << 32) | lo);
}

__device__ __forceinline__ bf16* wl(const Frame& F, int l, size_t off) { return (bf16*)(F.ws + P_W + (size_t)l * WL_BYTES) + off; }
#define PTR(type, off) ((type*)(F.ws + (off)))
#define SMALLP(type, off) ((type*)(F.ws + F_SMALL + (off)))

__device__ __forceinline__ int rope_pos(int i) { return 8 * ((i >> 2) & 3) + 4 * (i >> 4) + (i & 3); }
__device__ __forceinline__ int rope_feat(int rho) { return 16 * ((rho >> 2) & 1) + 4 * (rho >> 3) + (rho & 3); }
__device__ __forceinline__ void transpose_item(const float* W, int ldw, int k0, int c0, bf16* WT, int ldt, int drow, const float* gain, LAS float* scr, int lane, bool rperm = false) {
#pragma unroll 8
    for (int i = 0; i < 32; ++i) { const int kk = 2 * i + (lane >> 5); float v = W[(size_t)(k0 + kk) * ldw + c0 + (lane & 31)]; if (gain) v *= gain[k0 + kk]; scr[kk * 33 + (lane & 31)] = v; }
    LDS_WAIT(); asm volatile("" ::: "memory");
    const int c = lane & 7;
#pragma unroll
    for (int j = 0; j < 4; ++j) { const int n = (lane >> 3) + 8 * j; const LAS float* s = scr + (8 * c) * 33 + n;
        v4u o; o.x = pk2(s[0 * 33], s[1 * 33]); o.y = pk2(s[2 * 33], s[3 * 33]); o.z = pk2(s[4 * 33], s[5 * 33]); o.w = pk2(s[6 * 33], s[7 * 33]);
        *(v4u*)(WT + (size_t)(drow + (rperm ? rope_pos(n) : n)) * ldt + k0 + 8 * c) = o; }
    LDS_WAIT(); asm volatile("" ::: "memory");
}
constexpr int IT_IN = 16 * 45, IT_UQ = 4 * 24, IT_UKV = 2 * 32, IT_OUT = 16 * 32, IT_G = 32 * 16 * 8, IT_D = 32 * 4 * 32;
constexpr int IT_LAYER = IT_IN + IT_UQ + IT_UKV + IT_OUT + 2 * IT_G + IT_D;
__device__ __forceinline__ void p0_item(const Frame& F, int it, LAS float* scr) {
    const int l = it / IT_LAYER; int r = it % IT_LAYER; const int lane = F.lane;
    if (r < IT_IN) { const int kb = r / 45, cb = r % 45, c0 = 32 * cb;
        const int drow = c0 < 416 ? c0 : c0 < 672 ? 512 + (c0 - 416) : c0 < 928 ? 768 + (c0 - 672) : c0 < 1184 ? 1280 + (c0 - 928) : 1024 + (c0 - 1184);
        transpose_item(inp(F, 2) + (size_t)l * DM * DIN, DIN, 64 * kb, c0, wl(F, l, WO_IN), 1024, drow, inp(F, 1) + l * DM, scr, lane, c0 == 384); return; } r -= IT_IN;
    if (r < IT_UQ) { const int kb = r / 24, cb = r % 24, h = cb / 3, p = cb % 3; const int drow = p < 2 ? 64 * h + 32 * p : 512 + 32 * h;
        transpose_item(inp(F, 4) + (size_t)l * AQL * 768, 768, 64 * kb, 32 * cb, wl(F, l, WO_UQ), 256, drow, inp(F, 3) + l * AQL, scr, lane, p == 2); return; } r -= IT_UQ;
    if (r < IT_UKV) { const int kb = r / 32, cb = r % 32, h = cb / 4, p = cb % 4; const int drow = p < 2 ? 64 * h + 32 * p : 512 + 64 * h + 32 * (p - 2);
        transpose_item(inp(F, 6) + (size_t)l * AKVL * 1024, 1024, 64 * kb, 32 * cb, wl(F, l, WO_UKV), 256, drow, inp(F, 5) + l * AKVL, scr, lane); return; } r -= IT_UKV;
    if (r < IT_OUT) { const int kb = r / 32, cb = r % 32;
        transpose_item(inp(F, 9) + (size_t)l * DM * DM, DM, 64 * kb, 32 * cb, wl(F, l, WO_OUT), 1024, 32 * cb, nullptr, scr, lane); return; } r -= IT_OUT;
    if (r < 2 * IT_G) { const int up = r / IT_G; r %= IT_G; const int e = r / 128, q = r % 128, kb = q / 8, cb = q % 8;
        const int drow = e * 512 + 256 * (cb >> 2) + 32 * (cb & 3) + 128 * up;
        transpose_item((up ? inp(F, 16) : inp(F, 15)) + ((size_t)l * NEXP + e) * DM * DE, DE, 64 * kb, 32 * cb, wl(F, l, WO_GU), 1024, drow, inp(F, 10) + l * DM, scr, lane); return; } r -= 2 * IT_G;
    { const int e = r / 128, q = r % 128, kb = q / 32, cb = q % 32;
        transpose_item(inp(F, 17) + ((size_t)l * NEXP + e) * DE * DM, DM, 64 * kb, 32 * cb, wl(F, l, WO_D), 256, e * 1024 + 32 * cb, nullptr, scr, lane); }
}
__device__ __forceinline__ void row_to_bf16_rinv(const Frame& F, const float* xrow, bf16* orow, float* rinv) {
    const f32x4* xr = (const f32x4*)xrow + F.lane;
    f32x4 v[4]; float s = 0.f;
#pragma unroll
    for (int j = 0; j < 4; ++j) { v[j] = xr[64 * j]; s += (v[j].x * v[j].x + v[j].y * v[j].y) + (v[j].z * v[j].z + v[j].w * v[j].w); }
    s = wave_sum(s);
    if (F.lane == 0) *rinv = 1.0f / sqrtf(s * (1.0f / DM) + EPS);
    unsigned long long* o8 = (unsigned long long*)orow + F.lane;
#pragma unroll
    for (int j = 0; j < 4; ++j) o8[64 * j] = (unsigned long long)pk2(v[j].x, v[j].y) | ((unsigned long long)pk2(v[j].z, v[j].w) << 32);
}
__device__ __forceinline__ void phase_p0(const Frame& F) {
    LAS float* scr = (LAS float*)(F.lds + F.wave * 16384);
    for (int it = F.gw; it < DEPTH * IT_LAYER; it += NGW) p0_item(F, it, scr);
    for (int l = 0; l < DEPTH; ++l) {
        v4u z = {0u, 0u, 0u, 0u};
        for (int i = F.gtid; i < 96 * 1024 / 8; i += GT) *(v4u*)(wl(F, l, WO_IN) + (size_t)416 * 1024 + (size_t)i * 8) = z;
        for (int i = F.gtid; i < 1024 * 16; i += GT) { const int n = i >> 4, c = i & 15; *(v4u*)(wl(F, l, WO_UKV) + (size_t)n * 256 + 128 + c * 8) = z; }
        float* wr = PTR(float, WS_WR) + (size_t)l * 40 * 1024;
        for (int i = F.gtid; i < 40 * 1024; i += GT) { const int j = i >> 10, k = i & 1023; float v = 0.f;
            if (j < 4) v = inp(F, 11)[((size_t)l * DM + k) * 4 + j]; else if (j < 36) v = inp(F, 13)[((size_t)l * DM + k) * 32 + (j - 4)];
            wr[i] = v * inp(F, 10)[l * DM + k]; }
    }
    float* rope = PTR(float, WS_ROPE);
    for (int i = F.gtid; i < SEQ * 16; i += GT) { const int s = i >> 4, j = i & 15;
        const float inv = exp2f(-(float)(2 * j) * (1.0f / 32.0f) * 13.287712379549449f);
        const float ang = (float)s * inv;
        const double rev = (double)ang * 0.15915494309189535; const double fr = rev - floor(rev);
        const double a = fr * 6.283185307179586;
        rope[2 * i] = (float)cos(a); rope[2 * i + 1] = (float)sin(a); }
    bf16* xb = PTR(bf16, F_XB); float* rinv = SMALLP(float, SM_RINV);
    for (int m = F.gw; m < NTOK; m += NGW) row_to_bf16_rinv(F, inp(F, 0) + (size_t)m * DM, xb + (size_t)m * DM, rinv + m);
}

__device__ __forceinline__ void phase_a1(const Frame& F, int l) {
    const bf16* xb = PTR(bf16, F_XB); const bf16* w = wl(F, l, WO_IN); const float* rinv = SMALLP(float, SM_RINV); const float* rope = PTR(float, WS_ROPE);
    bf16* CQ = PTR(bf16, F_CQ); bf16* CKVX = PTR(bf16, F_CKVX); bf16* KR = PTR(bf16, F_KR); bf16* U = PTR(bf16, F_U); bf16* SBQ = PTR(bf16, F_SBQ); bf16* SBK = PTR(bf16, F_SBK); bf16* SBVT = PTR(bf16, F_SBVT);
    float* SSQQ = SMALLP(float, SM_SSQQ); float* SSQKV = SMALLP(float, SM_SSQKV);
    for (size_t idx = F.gtid; idx < (size_t)NTOK * NPAD; idx += GT) {
        const int t = (int)(idx / NPAD), n = (int)(idx % NPAD), b = t >> 12, s = t & 4095;
        float val = 0.f;
        if (!(n >= 416 && n < 512)) val = dot_bf16(xb + (size_t)t * DM, w + (size_t)n * DM, DM) * rinv[t];
        const float other = __shfl_xor(val, 4);
        if (n < 256) { CQ[(size_t)t * 256 + n] = (bf16)f2bf(val); const float q = wave_sum(val * val); if (F.lane == 0) SSQQ[t * 4 + (n >> 6)] = q; }
        else if (n < 512) { CKVX[(size_t)t * 256 + (n - 256)] = (bf16)f2bf(val);
            if (n < 384) { const float q = wave_sum(val * val); if (F.lane == 0) { SSQKV[t * 4 + ((n - 256) >> 6)] = q; SSQKV[t * 4 + 2 + ((n - 256) >> 6)] = 0.f; } }
            else if (n < 416) { const int i = rope_feat(n - 384), j = i & 15; const float c = rope[(s * 16 + j) * 2], sn = rope[(s * 16 + j) * 2 + 1];
                const float o = i < 16 ? val * c - other * sn : val * c + other * sn; KR[idx_KR(b, s, i)] = (bf16)f2bf(o); } }
        else if (n < 768) { const int h = (n - 512) >> 6, d = (n - 512) & 63; SBQ[idx_SB(b, h, s, d)] = (bf16)f2bf(val * QSCALE_B); }
        else if (n < 1024) { const int h = (n - 768) >> 6, d = (n - 768) & 63; SBK[idx_SB(b, h, s, d)] = (bf16)f2bf(val); }
        else if (n < 1280) { U[(size_t)t * 256 + (n - 1024)] = (bf16)f2bf(val); }
        else { SBVT[(size_t)(n - 1280) * NTOK + perm16(t)] = (bf16)f2bf(val); }
    }
}

__device__ __forceinline__ void phase_a2(const Frame& F, int l) {
    const bf16* CQ = PTR(bf16, F_CQ); const bf16* CKVX = PTR(bf16, F_CKVX); const float* SSQQ = SMALLP(float, SM_SSQQ); const float* SSQKV = SMALLP(float, SM_SSQKV); const float* rope = PTR(float, WS_ROPE);
    bf16* Q = PTR(bf16, F_Q); bf16* KN = PTR(bf16, F_KN); bf16* VT = PTR(bf16, F_VT);
    const bf16* wq = wl(F, l, WO_UQ); const bf16* wkv = wl(F, l, WO_UKV);
    for (size_t idx = F.gtid; idx < (size_t)NTOK * 768; idx += GT) {
        const int t = (int)(idx / 768), n = (int)(idx % 768), b = t >> 12, s = t & 4095;
        const float rq = 1.0f / sqrtf((SSQQ[t * 4] + SSQQ[t * 4 + 1] + SSQQ[t * 4 + 2] + SSQQ[t * 4 + 3]) * (1.0f / AQL) + EPS);
        const float val = dot_bf16(CQ + (size_t)t * 256, wq + (size_t)n * 256, 256) * rq;
        const float other = __shfl_xor(val, 4);
        if (n < 512) { Q[idx_Q(b, n >> 6, s, n & 63)] = (bf16)f2bf(val * QSCALE_A); }
        else { const int h = (n - 512) >> 5, i = rope_feat((n - 512) & 31), j = i & 15; const float c = rope[(s * 16 + j) * 2], sn = rope[(s * 16 + j) * 2 + 1];
            const float o = i < 16 ? val * c - other * sn : val * c + other * sn; Q[idx_Q(b, h, s, 64 + i)] = (bf16)f2bf(o * QSCALE_A); }
    }
    for (size_t idx = F.gtid; idx < (size_t)NTOK * 1024; idx += GT) {
        const int t = (int)(idx >> 10), n = (int)(idx & 1023), b = t >> 12, s = t & 4095;
        const float rkv = 1.0f / sqrtf((SSQKV[t * 4] + SSQKV[t * 4 + 1] + SSQKV[t * 4 + 2] + SSQKV[t * 4 + 3]) * (1.0f / AKVL) + EPS);
        const float val = dot_bf16(CKVX + (size_t)t * 256, wkv + (size_t)n * 256, 256) * rkv;
        if (n < 512) KN[idx_KN(b, n >> 6, s, n & 63)] = (bf16)f2bf(val);
        else VT[(size_t)(n - 512) * NTOK + perm16(t)] = (bf16)f2bf(val);
    }
}

__device__ __forceinline__ void phase_a3(const Frame& F, int l) {
    const bf16* Q = PTR(bf16, F_Q); const bf16* KN = PTR(bf16, F_KN); const bf16* VT = PTR(bf16, F_VT); const bf16* KR = PTR(bf16, F_KR);
    const bf16* SBQ = PTR(bf16, F_SBQ); const bf16* SBK = PTR(bf16, F_SBK); const bf16* SBVT = PTR(bf16, F_SBVT); const bf16* U = PTR(bf16, F_U);
    bf16* MIX = PTR(bf16, F_MIX);
    for (int idx = F.gtid; idx < NBATCH * AH * SEQ; idx += GT) {
        const int s = idx & 4095, h = (idx >> 12) & 7, b = idx >> 15;
        unsigned qp[48];
#pragma unroll
        for (int i = 0; i < 12; ++i) { const v4u v = *(const v4u*)(Q + idx_Q(b, h, s, 8 * i)); qp[4 * i] = v.x; qp[4 * i + 1] = v.y; qp[4 * i + 2] = v.z; qp[4 * i + 3] = v.w; }
        float acc[64];
#pragma unroll
        for (int d = 0; d < 64; ++d) acc[d] = 0.f;
        float m = -INFINITY, lsum = 0.f;
        const int nkeys = ((s >> 6) + 1) * 64;
        for (int key = 0; key < nkeys; ++key) {
            float sc = 0.f;
#pragma unroll
            for (int c = 0; c < 8; ++c) { const v4u kv = *(const v4u*)(KN + idx_KN(b, h, key, 8 * c));
                sc += bflo(qp[4 * c]) * bflo(kv.x) + bfhi(qp[4 * c]) * bfhi(kv.x) + bflo(qp[4 * c + 1]) * bflo(kv.y) + bfhi(qp[4 * c + 1]) * bfhi(kv.y)
                    + bflo(qp[4 * c + 2]) * bflo(kv.z) + bfhi(qp[4 * c + 2]) * bfhi(kv.z) + bflo(qp[4 * c + 3]) * bflo(kv.w) + bfhi(qp[4 * c + 3]) * bfhi(kv.w); }
#pragma unroll
            for (int c = 0; c < 4; ++c) { const v4u kv = *(const v4u*)(KR + idx_KR(b, key, 8 * c)); const int o = 32 + 4 * c;
                sc += bflo(qp[o]) * bflo(kv.x) + bfhi(qp[o]) * bfhi(kv.x) + bflo(qp[o + 1]) * bflo(kv.y) + bfhi(qp[o + 1]) * bfhi(kv.y)
                    + bflo(qp[o + 2]) * bflo(kv.z) + bfhi(qp[o + 2]) * bfhi(kv.z) + bflo(qp[o + 3]) * bflo(kv.w) + bfhi(qp[o + 3]) * bfhi(kv.w); }
            const float mn = fmaxf(m, sc), f = exp2f(m - mn), p = exp2f(sc - mn);
            lsum = lsum * f + p; m = mn;
            const size_t vcol = (size_t)perm16(b * SEQ + key);
#pragma unroll
            for (int d = 0; d < 64; ++d) acc[d] = acc[d] * f + p * bf2f(VT[(size_t)(h * 64 + d) * NTOK + vcol]);
        }
        const float il = 1.0f / lsum;
#pragma unroll
        for (int d = 0; d < 64; d += 2) *(unsigned*)(MIX + (size_t)(b * SEQ + s) * DM + h * 64 + d) = pk2(acc[d] * il, acc[d + 1] * il);
    }
    for (int idx = F.gtid; idx < NBATCH * BHD * SEQ; idx += GT) {
        const int s = idx & 4095, h = (idx >> 12) & 3, b = idx >> 14;
        unsigned qp[32];
#pragma unroll
        for (int i = 0; i < 8; ++i) { const v4u v = *(const v4u*)(SBQ + idx_SB(b, h, s, 8 * i)); qp[4 * i] = v.x; qp[4 * i + 1] = v.y; qp[4 * i + 2] = v.z; qp[4 * i + 3] = v.w; }
        float acc[64];
#pragma unroll
        for (int d = 0; d < 64; ++d) acc[d] = 0.f;
        float carry = 0.f;
        for (int key = s - 1; key >= 0; --key) {
            float z = 0.f;
#pragma unroll
            for (int c = 0; c < 8; ++c) { const v4u kv = *(const v4u*)(SBK + idx_SB(b, h, key, 8 * c));
                z += bflo(qp[4 * c]) * bflo(kv.x) + bfhi(qp[4 * c]) * bfhi(kv.x) + bflo(qp[4 * c + 1]) * bflo(kv.y) + bfhi(qp[4 * c + 1]) * bfhi(kv.y)
                   + bflo(qp[4 * c + 2]) * bflo(kv.z) + bfhi(qp[4 * c + 2]) * bfhi(kv.z) + bflo(qp[4 * c + 3]) * bflo(kv.w) + bfhi(qp[4 * c + 3]) * bfhi(kv.w); }
            const float sp = fmaxf(z, 0.f) + log2f(1.0f + exp2f(-fabsf(z)));
            const float a = exp2f(z - sp + carry);
            carry -= sp;
            const size_t vcol = (size_t)perm16(b * SEQ + key);
#pragma unroll
            for (int d = 0; d < 64; ++d) acc[d] += a * bf2f(SBVT[(size_t)(h * 64 + d) * NTOK + vcol]);
        }
#pragma unroll
        for (int d = 0; d < 64; d += 2) *(unsigned*)(MIX + (size_t)(b * SEQ + s) * DM + 512 + h * 64 + d) = pk2(acc[d], acc[d + 1]);
    }
    const float* pw = inp(F, 7) + (size_t)l * 4 * 64 * 64; const float* ps = inp(F, 8) + l * 256;
    for (int idx = F.gtid; idx < NTOK * 256; idx += GT) {
        const int t = idx >> 8, cc = idx & 255, g = cc >> 6, co = cc & 63, s = t & 4095, w = 2 << g;
        const int cnt = (s + 1) < w ? (s + 1) : w; const float ic = 1.0f / (float)cnt;
        float acc = 0.f;
        for (int c = 0; c < 64; ++c) {
            float sum = 0.f;
            for (int j = 0; j < cnt; ++j) sum += bf2f(U[(size_t)(t - j) * 256 + g * 64 + c]);
            const float d = sum * ic - bf2f(U[(size_t)t * 256 + g * 64 + c]);
            acc += d * pw[(g * 64 + c) * 64 + co];
        }
        MIX[(size_t)t * DM + 768 + cc] = (bf16)f2bf(acc * ps[cc]);
    }
}

__device__ __forceinline__ void phase_a4(const Frame& F, int l) {
    const bf16* MIX = PTR(bf16, F_MIX); const bf16* w = wl(F, l, WO_OUT); bf16* xb = PTR(bf16, F_XB);
    const float* xin = l == 0 ? inp(F, 0) : F.X;
    for (size_t idx = F.gtid; idx < (size_t)NTOK * DM; idx += GT) {
        const int t = (int)(idx >> 10), n = (int)(idx & 1023);
        const float v = xin[idx] + dot_bf16(MIX + (size_t)t * DM, w + (size_t)n * DM, DM);
        F.X[idx] = v; xb[idx] = (bf16)f2bf(v);
    }
}

__device__ __forceinline__ void phase_m1(const Frame& F, int l) {
    const float* wr = PTR(float, WS_WR) + (size_t)l * 40 * 1024; const float* bg = inp(F, 12) + l * 4; const float* be = inp(F, 14) + l * 32;
    float* R2 = SMALLP(float, SM_R2); int* RTE = SMALLP(int, SM_RTE); int* RTPOS = SMALLP(int, SM_RTPOS); float* RTC = SMALLP(float, SM_RTC);
    unsigned* cnt = F.ctl + CW_CNT + l * 32;
    for (int t = F.gw; t < NTOK; t += NGW) {
        float xv[16]; float ss = 0.f;
#pragma unroll
        for (int i = 0; i < 16; ++i) { xv[i] = F.X[(size_t)t * DM + F.lane + 64 * i]; ss += xv[i] * xv[i]; }
        ss = wave_sum(ss);
        const float r2 = 1.0f / sqrtf(ss * (1.0f / DM) + EPS);
        float l0 = 0.f, l1 = 0.f, l2 = 0.f, l3 = 0.f;
#pragma unroll 1
        for (int j = 0; j < 4; ++j) { const float* wp = wr + j * 1024 + F.lane; float p = 0.f;
#pragma unroll
            for (int i = 0; i < 16; ++i) p += xv[i] * wp[64 * i];
            const float v = wave_sum(p) * r2 + bg[j];
            l0 = j == 0 ? v : l0; l1 = j == 1 ? v : l1; l2 = j == 2 ? v : l2; l3 = j == 3 ? v : l3; }
        int g = 0; float gm = l0;
        if (l1 > gm) { gm = l1; g = 1; }
        if (l2 > gm) { gm = l2; g = 2; }
        if (l3 > gm) { gm = l3; g = 3; }
        const float psel = 1.0f / (expf(l0 - gm) + expf(l1 - gm) + expf(l2 - gm) + expf(l3 - gm));
        g = __builtin_amdgcn_readfirstlane(g);
        int i1 = 0, i2 = 0; float m1 = -INFINITY, m2 = -INFINITY;
#pragma unroll 1
        for (int e = 0; e < 8; ++e) { const float* wp = wr + (size_t)(4 + 8 * g + e) * 1024 + F.lane; float p = 0.f;
#pragma unroll
            for (int i = 0; i < 16; ++i) p += xv[i] * wp[64 * i];
            const float v = wave_sum(p) * r2 + be[8 * g + e];
            if (v > m1) { m2 = m1; i2 = i1; m1 = v; i1 = e; } else if (v > m2) { m2 = v; i2 = e; } }
        const float ex = expf(m2 - m1), w1 = 1.0f / (1.0f + ex), w2 = ex / (1.0f + ex);
        if (F.lane == 0) {
            const int e1 = g * 8 + i1, e2 = g * 8 + i2;
            const unsigned p1 = atomicAdd(cnt + e1, 1u), p2 = atomicAdd(cnt + e2, 1u);
            R2[t] = r2; RTE[2 * t] = e1; RTE[2 * t + 1] = e2; RTPOS[2 * t] = (int)p1; RTPOS[2 * t + 1] = (int)p2; RTC[2 * t] = psel * w1; RTC[2 * t + 1] = psel * w2;
        }
    }
}
constexpr int LDS_TAB = 131072 + 1024;
__device__ __forceinline__ void moe_offsets(const Frame& F, int l) {
    LAS int* off = (LAS int*)(F.lds + LDS_TAB); LAS int* cn = (LAS int*)(F.lds + LDS_TAB + 256); LAS int* te = (LAS int*)(F.lds + LDS_TAB + 512);
    __syncthreads();
    if (F.tid == 0) { int a = 0; for (int e = 0; e < 32; ++e) { const int c = (int)__hip_atomic_load(F.ctl + CW_CNT + l * 32 + e, RLX_AGENT); off[e] = a; cn[e] = c;
            const int np = (c + 255) & ~255; for (int tt = a >> 8; tt < ((a + np) >> 8); ++tt) te[tt] = e; a += np; } off[32] = a; }
    __syncthreads();
}
__device__ __forceinline__ int find_expert(LAS int* off, int r) { int e = 0; for (int j = 1; j < 32; ++j) if (r >= off[j]) e = j; return e; }

__device__ __forceinline__ void phase_m2(const Frame& F, int l) {
    moe_offsets(F, l);
    LAS int* off = (LAS int*)(F.lds + LDS_TAB); LAS int* cn = (LAS int*)(F.lds + LDS_TAB + 256);
    const float* R2 = SMALLP(float, SM_R2); const int* RTE = SMALLP(int, SM_RTE); const int* RTPOS = SMALLP(int, SM_RTPOS); const float* RTC = SMALLP(float, SM_RTC);
    int* TROW = SMALLP(int, SM_TROW); float* ROWR2 = SMALLP(float, SM_ROWR2); float* ROWC = SMALLP(float, SM_ROWC); int* ROWTOK = SMALLP(int, SM_ROWTOK);
    for (int idx = F.gtid; idx < NTOK * 2; idx += GT) { const int t = idx >> 1, e = RTE[idx], row = off[e] + RTPOS[idx];
        ROWTOK[row] = t; ROWC[row] = RTC[idx]; ROWR2[row] = R2[t]; TROW[idx] = row; }
    const int rtot = off[32];
    for (int r = F.gtid; r < rtot; r += GT) { const int e = find_expert(off, r); if (r - off[e] >= cn[e]) { ROWTOK[r] = 0; ROWC[r] = 0.f; ROWR2[r] = 0.f; } }
}
__device__ __forceinline__ void phase_m3(const Frame& F, int l) {
    moe_offsets(F, l);
    LAS int* off = (LAS int*)(F.lds + LDS_TAB); LAS int* cn = (LAS int*)(F.lds + LDS_TAB + 256);
    const bf16* xb = PTR(bf16, F_XB); const bf16* w = wl(F, l, WO_GU); bf16* H = PTR(bf16, F_H);
    const float* ROWR2 = SMALLP(float, SM_ROWR2); const float* ROWC = SMALLP(float, SM_ROWC); const int* ROWTOK = SMALLP(int, SM_ROWTOK);
    const int rtot = off[32];
    for (size_t idx = F.gtid; idx < (size_t)rtot * 256; idx += GT) {
        const int r = (int)(idx >> 8), f = (int)(idx & 255), e = find_expert(off, r);
        if (r - off[e] >= cn[e]) continue;
        const bf16* xr = xb + (size_t)ROWTOK[r] * DM; const bf16* wg = w + ((size_t)e * 512 + 256 * (f >> 7) + (f & 127)) * DM;
        const float r2 = ROWR2[r]; const float a = dot_bf16(xr, wg, DM) * r2, bb = dot_bf16(xr, wg + (size_t)128 * DM, DM) * r2;
        H[(size_t)r * 256 + f] = (bf16)f2bf(a / (1.0f + expf(-a)) * bb * ROWC[r]);
    }
}
__device__ __forceinline__ void phase_m4(const Frame& F, int l) {
    moe_offsets(F, l);
    LAS int* off = (LAS int*)(F.lds + LDS_TAB); LAS int* cn = (LAS int*)(F.lds + LDS_TAB + 256);
    const bf16* H = PTR(bf16, F_H); const bf16* w = wl(F, l, WO_D); bf16* Y = PTR(bf16, F_Y);
    const int rtot = off[32];
    for (size_t idx = F.gtid; idx < (size_t)rtot * 1024; idx += GT) {
        const int r = (int)(idx >> 10), n = (int)(idx & 1023), e = find_expert(off, r);
        if (r - off[e] >= cn[e]) continue;
        Y[idx] = (bf16)f2bf(dot_bf16(H + (size_t)r * 256, w + ((size_t)e * 1024 + n) * 256, 256));
    }
}
__device__ __forceinline__ void phase_m5(const Frame& F, int l) {
    const bf16* Y = PTR(bf16, F_Y); const int* TROW = SMALLP(int, SM_TROW); bf16* xb = PTR(bf16, F_XB); float* rinv = SMALLP(float, SM_RINV);
    for (int t = F.gw; t < NTOK; t += NGW) {
        const int r0 = TROW[2 * t], r1 = TROW[2 * t + 1];
        float xv[16]; float ss = 0.f;
#pragma unroll
        for (int i = 0; i < 16; ++i) { const int c = F.lane + 64 * i; xv[i] = F.X[(size_t)t * DM + c] + bf2f(Y[(size_t)r0 * DM + c]) + bf2f(Y[(size_t)r1 * DM + c]); ss += xv[i] * xv[i]; }
        ss = wave_sum(ss);
        const float r = 1.0f / sqrtf(ss * (1.0f / DM) + EPS);
        if (l == DEPTH - 1) {
#pragma unroll
            for (int i = 0; i < 16; ++i) { const int c = F.lane + 64 * i; F.X[(size_t)t * DM + c] = xv[i] * r * inp(F, 18)[c]; }
        } else {
#pragma unroll
            for (int i = 0; i < 16; ++i) { const int c = F.lane + 64 * i; F.X[(size_t)t * DM + c] = xv[i]; xb[(size_t)t * DM + c] = (bf16)f2bf(xv[i]); }
            if (F.lane == 0) rinv[t] = r;
        }
    }
}


#ifndef FAST_A3
#define FAST_A3 1
#endif
namespace attn {
typedef short bf16x8 __attribute__((ext_vector_type(8)));
typedef float f32x16 __attribute__((ext_vector_type(16)));
typedef unsigned u32x4 __attribute__((ext_vector_type(4)));
constexpr int KSLOT = 12288, VSLOT = 8192, SLOT = KSLOT + VSLOT;
constexpr int LDS_WSF = 2 * SLOT, LDS_OST = LDS_WSF + NWAVES * 256, LDS_END = LDS_OST + NWAVES * 4096;
static_assert(LDS_END <= 131072, "attention LDS");
__device__ __forceinline__ int crow(int r, int hi) { return (r & 3) + 8 * (r >> 2) + 4 * hi; }
__device__ __forceinline__ unsigned cvtpk(float lo, float hi) { unsigned r; asm("v_cvt_pk_bf16_f32 %0, %1, %2" : "=v"(r) : "v"(lo), "v"(hi)); return r; }
__device__ __forceinline__ bf16x8 pack_frag(const f32x16& p, int base) {
    u32x4 w; w.x = cvtpk(p[base], p[base + 1]); w.y = cvtpk(p[base + 2], p[base + 3]); w.z = cvtpk(p[base + 4], p[base + 5]); w.w = cvtpk(p[base + 6], p[base + 7]);
    return __builtin_bit_cast(bf16x8, w);
}
__device__ __forceinline__ float half_max(float v) { auto rr = __builtin_amdgcn_permlane32_swap(__float_as_uint(v), __float_as_uint(v), false, false); return fmaxf(__uint_as_float(rr[0]), __uint_as_float(rr[1])); }
__device__ __forceinline__ float half_sum(float v) { auto rr = __builtin_amdgcn_permlane32_swap(__float_as_uint(v), __float_as_uint(v), false, false); return __uint_as_float(rr[0]) + __uint_as_float(rr[1]); }
__device__ __forceinline__ void store_o(LAS unsigned char* lds, int w, int lane, const f32x16& o0, const f32x16& o1, bf16* dst) {
    const int r32 = lane & 31, hi = lane >> 5;
    LAS bf16* stg = (LAS bf16*)(lds + LDS_OST + w * 4096);
#pragma unroll
    for (int r = 0; r < 16; ++r) { const int q = crow(r, hi); stg[q * 64 + r32] = (bf16)(cvtpk(o0[r], 0.f) & 0xffffu); stg[q * 64 + 32 + r32] = (bf16)(cvtpk(o1[r], 0.f) & 0xffffu); }
#pragma unroll
    for (int i = 0; i < 4; ++i) { const int row = i * 8 + (lane >> 3), ch = lane & 7; const u32x4 v = *(const LAS u32x4*)(stg + row * 64 + ch * 8); *(u32x4*)(dst + (size_t)row * DM + ch * 8) = v; }
}
__device__ __forceinline__ void mla_unit(const Frame& F, int b, int h, int qb) {
    const int lane = F.lane, w = F.wave, r32 = lane & 31, hi = lane >> 5;
    LAS unsigned char* lds = F.lds;
    const bf16* Q = PTR(bf16, F_Q); const bf16* KN = PTR(bf16, F_KN); const bf16* KR = PTR(bf16, F_KR); const bf16* VT = PTR(bf16, F_VT); bf16* MIX = PTR(bf16, F_MIX);
    const int s0 = qb * 256 + w * 32, cq = s0 >> 6, NT = 4 * qb + 4;
    bf16x8 qr[6];
    { const bf16* qrow = Q + idx_Q(b, h, s0 + r32, 0);
#pragma unroll
      for (int d0 = 0; d0 < 6; ++d0) qr[d0] = *(const bf16x8*)(qrow + 16 * d0 + 8 * hi); }
    f32x16 o0, o1;
#pragma unroll
    for (int r = 0; r < 16; ++r) { o0[r] = 0.f; o1[r] = 0.f; }
    float mref = -INFINITY, lsum = 0.f;
    LAS float* wsf = (LAS float*)(lds + LDS_WSF) + w * 64;
    const bf16* kn_src = KN + ((((size_t)b * 8 + h) * 64) * 8 + w) * 512 + lane * 8;
    const bf16* kr_src = KR + ((((size_t)b * 64) * 4) + (w & 3)) * 512 + lane * 8;
    const int vd = 8 * w + (lane >> 3), vch = (lane & 7) ^ ((vd >> 1) & 7);
    const bf16* v_src = VT + (size_t)(h * 64 + vd) * NTOK + b * SEQ + vch * 8;
#define MLA_DMA(kt, buf) do { LAS unsigned char* base_ = lds + (buf) * SLOT; \
        __builtin_amdgcn_global_load_lds((const unsigned*)(kn_src + (size_t)(kt) * 4096), (LAS unsigned*)(base_ + w * 1024), 16, 0, 0); \
        if (w < 4) __builtin_amdgcn_global_load_lds((const unsigned*)(kr_src + (size_t)(kt) * 2048), (LAS unsigned*)(base_ + (8 + w) * 1024), 16, 0, 0); \
        __builtin_amdgcn_global_load_lds((const unsigned*)(v_src + (size_t)(kt) * 64), (LAS unsigned*)(base_ + KSLOT + w * 1024), 16, 0, 0); } while (0)
    MLA_DMA(0, 0);
#pragma unroll 1
    for (int kt = 0; kt < NT; ++kt) {
        const int buf = kt & 1;
        asm volatile("s_waitcnt vmcnt(0)" ::: "memory");
        __builtin_amdgcn_s_barrier(); asm volatile("" ::: "memory");
        if (kt + 1 < NT) MLA_DMA(kt + 1, buf ^ 1);
        if (kt <= cq) {
            const LAS unsigned char* kb = lds + buf * SLOT + hi * 1024 + r32 * 16;
            f32x16 p0, p1;
#pragma unroll
            for (int r = 0; r < 16; ++r) { p0[r] = 0.f; p1[r] = 0.f; }
#pragma unroll
            for (int d0 = 0; d0 < 6; ++d0) { const bf16x8 a0 = *(const LAS bf16x8*)(kb + d0 * 2048), a1 = *(const LAS bf16x8*)(kb + d0 * 2048 + 512);
                p0 = __builtin_amdgcn_mfma_f32_32x32x16_bf16(a0, qr[d0], p0, 0, 0, 0); p1 = __builtin_amdgcn_mfma_f32_32x32x16_bf16(a1, qr[d0], p1, 0, 0, 0); }
            float mt = fmaxf(p0[0], p1[0]);
#pragma unroll
            for (int r = 1; r < 16; ++r) mt = fmaxf(mt, fmaxf(p0[r], p1[r]));
            mt = half_max(mt);
            if (__any(mt > mref + 6.0f)) {
                const float mn = fmaxf(mref, mt), alpha = __builtin_amdgcn_exp2f(mref - mn);
                lsum *= alpha; mref = mn;
                if (hi == 0) wsf[r32] = alpha;
#pragma unroll
                for (int r = 0; r < 16; ++r) { const float f = wsf[crow(r, hi)]; o0[r] *= f; o1[r] *= f; }
            }
            float ls0 = 0.f, ls1 = 0.f;
#pragma unroll
            for (int r = 0; r < 16; ++r) { p0[r] = __builtin_amdgcn_exp2f(p0[r] - mref); p1[r] = __builtin_amdgcn_exp2f(p1[r] - mref); ls0 += p0[r]; ls1 += p1[r]; }
            lsum += ls0 + ls1;
            const bf16x8 pa0 = pack_frag(p0, 0), pa1 = pack_frag(p0, 8), pa2 = pack_frag(p1, 0), pa3 = pack_frag(p1, 8);
            const LAS unsigned char* vb = lds + buf * SLOT + KSLOT;
#pragma unroll
            for (int dv = 0; dv < 2; ++dv) { const int d = 32 * dv + r32, sw = (d >> 1) & 7; const LAS unsigned char* vr = vb + d * 128;
                const bf16x8 v0 = *(const LAS bf16x8*)(vr + (((0 + hi) ^ sw) << 4)), v1 = *(const LAS bf16x8*)(vr + (((2 + hi) ^ sw) << 4)),
                             v2 = *(const LAS bf16x8*)(vr + (((4 + hi) ^ sw) << 4)), v3 = *(const LAS bf16x8*)(vr + (((6 + hi) ^ sw) << 4));
                if (dv == 0) { o0 = __builtin_amdgcn_mfma_f32_32x32x16_bf16(pa0, v0, o0, 0, 0, 0); o0 = __builtin_amdgcn_mfma_f32_32x32x16_bf16(pa1, v1, o0, 0, 0, 0);
                               o0 = __builtin_amdgcn_mfma_f32_32x32x16_bf16(pa2, v2, o0, 0, 0, 0); o0 = __builtin_amdgcn_mfma_f32_32x32x16_bf16(pa3, v3, o0, 0, 0, 0); }
                else         { o1 = __builtin_amdgcn_mfma_f32_32x32x16_bf16(pa0, v0, o1, 0, 0, 0); o1 = __builtin_amdgcn_mfma_f32_32x32x16_bf16(pa1, v1, o1, 0, 0, 0);
                               o1 = __builtin_amdgcn_mfma_f32_32x32x16_bf16(pa2, v2, o1, 0, 0, 0); o1 = __builtin_amdgcn_mfma_f32_32x32x16_bf16(pa3, v3, o1, 0, 0, 0); }
            }
        }
    }
#undef MLA_DMA
    const float inv = 1.0f / half_sum(lsum);
    if (hi == 0) wsf[32 + r32] = inv;
#pragma unroll
    for (int r = 0; r < 16; ++r) { const float f = wsf[32 + crow(r, hi)]; o0[r] *= f; o1[r] *= f; }
    store_o(lds, w, lane, o0, o1, MIX + (size_t)(b * SEQ + s0) * DM + h * 64);
}
__device__ __forceinline__ void sb_task(const Frame& F, int task) {
    const int lane = F.lane, w = F.wave, r32 = lane & 31, hi = lane >> 5;
    const int bh = task >> 7, blk = task & 127, b = bh >> 2, h = bh & 3, q0 = blk * 32, q = q0 + r32;
    const bf16* SBQ = PTR(bf16, F_SBQ); const bf16* SBK = PTR(bf16, F_SBK); const bf16* SBVT = PTR(bf16, F_SBVT); bf16* MIX = PTR(bf16, F_MIX);
    bf16x8 qr[4];
    { const bf16* qrow = SBQ + idx_SB(b, h, q, 0);
#pragma unroll
      for (int d0 = 0; d0 < 4; ++d0) qr[d0] = *(const bf16x8*)(qrow + 16 * d0 + 8 * hi); }
    f32x16 o0, o1;
#pragma unroll
    for (int r = 0; r < 16; ++r) { o0[r] = 0.f; o1[r] = 0.f; }
    float carry = 0.f;
    const bf16* kbase = SBK + idx_SB(b, h, 0, 0) + (size_t)r32 * 64 + 8 * hi;
    const bf16* vbase = SBVT + (size_t)(h * 64 + r32) * NTOK + b * SEQ + 8 * hi;
    const int ktd = q0 >> 6;
#pragma unroll 1
    for (int kt = ktd; kt >= 0; --kt) {
        f32x16 p0, p1;
#pragma unroll
        for (int r = 0; r < 16; ++r) { p0[r] = 0.f; p1[r] = 0.f; }
        const bf16* kp = kbase + (size_t)kt * 64 * 64;
#pragma unroll
        for (int d0 = 0; d0 < 4; ++d0) { const bf16x8 a0 = *(const bf16x8*)(kp + 16 * d0), a1 = *(const bf16x8*)(kp + 32 * 64 + 16 * d0);
            p0 = __builtin_amdgcn_mfma_f32_32x32x16_bf16(a0, qr[d0], p0, 0, 0, 0); p1 = __builtin_amdgcn_mfma_f32_32x32x16_bf16(a1, qr[d0], p1, 0, 0, 0); }
        f32x16 s0, s1; const bool diag = (kt == ktd); const int kb0 = kt * 64 + 4 * hi;
#pragma unroll
        for (int r = 0; r < 16; ++r) { const int key = kb0 + (r & 3) + 8 * (r >> 2);
            const float z0 = p0[r], z1 = p1[r];
            float a = fmaxf(z0, 0.f) + __builtin_amdgcn_logf(1.0f + __builtin_amdgcn_exp2f(-fabsf(z0)));
            float c = fmaxf(z1, 0.f) + __builtin_amdgcn_logf(1.0f + __builtin_amdgcn_exp2f(-fabsf(z1)));
            if (diag) { if (key >= q) { a = 0.f; p0[r] = -INFINITY; } if (key + 32 >= q) { c = 0.f; p1[r] = -INFINITY; } }
            s0[r] = a; s1[r] = c; }
        float gs[8];
#pragma unroll
        for (int g = 0; g < 4; ++g) { gs[g] = (s0[4 * g] + s0[4 * g + 1]) + (s0[4 * g + 2] + s0[4 * g + 3]); gs[4 + g] = (s1[4 * g] + s1[4 * g + 1]) + (s1[4 * g + 2] + s1[4 * g + 3]); }
        float GS[16];
#pragma unroll
        for (int k = 0; k < 8; ++k) { auto rr = __builtin_amdgcn_permlane32_swap(__float_as_uint(gs[k]), __float_as_uint(gs[k]), false, false); GS[2 * k] = __uint_as_float(rr[0]); GS[2 * k + 1] = __uint_as_float(rr[1]); }
        float T[16]; T[15] = 0.f;
#pragma unroll
        for (int G = 14; G >= 0; --G) T[G] = T[G + 1] + GS[G + 1];
#pragma unroll
        for (int k = 0; k < 8; ++k) {
            float run = carry - (hi ? T[2 * k + 1] : T[2 * k]);
#pragma unroll
            for (int e = 3; e >= 0; --e) { const int r = 4 * (k & 3) + e;
                if (k < 4) { const float sp = s0[r]; p0[r] = __builtin_amdgcn_exp2f(p0[r] - sp + run); run -= sp; }
                else       { const float sp = s1[r]; p1[r] = __builtin_amdgcn_exp2f(p1[r] - sp + run); run -= sp; } }
        }
        carry -= T[0] + GS[0];
        const bf16x8 pa0 = pack_frag(p0, 0), pa1 = pack_frag(p0, 8), pa2 = pack_frag(p1, 0), pa3 = pack_frag(p1, 8);
        const bf16* vp = vbase + kt * 64;
#pragma unroll
        for (int dv = 0; dv < 2; ++dv) { const bf16* vr = vp + (size_t)(32 * dv) * NTOK;
            const bf16x8 v0 = *(const bf16x8*)(vr), v1 = *(const bf16x8*)(vr + 16), v2 = *(const bf16x8*)(vr + 32), v3 = *(const bf16x8*)(vr + 48);
            if (dv == 0) { o0 = __builtin_amdgcn_mfma_f32_32x32x16_bf16(pa0, v0, o0, 0, 0, 0); o0 = __builtin_amdgcn_mfma_f32_32x32x16_bf16(pa1, v1, o0, 0, 0, 0);
                           o0 = __builtin_amdgcn_mfma_f32_32x32x16_bf16(pa2, v2, o0, 0, 0, 0); o0 = __builtin_amdgcn_mfma_f32_32x32x16_bf16(pa3, v3, o0, 0, 0, 0); }
            else         { o1 = __builtin_amdgcn_mfma_f32_32x32x16_bf16(pa0, v0, o1, 0, 0, 0); o1 = __builtin_amdgcn_mfma_f32_32x32x16_bf16(pa1, v1, o1, 0, 0, 0);
                           o1 = __builtin_amdgcn_mfma_f32_32x32x16_bf16(pa2, v2, o1, 0, 0, 0); o1 = __builtin_amdgcn_mfma_f32_32x32x16_bf16(pa3, v3, o1, 0, 0, 0); }
        }
        if (__all(carry < -160.0f)) break;
    }
    store_o(F.lds, w, lane, o0, o1, MIX + (size_t)(b * SEQ + q0) * DM + 512 + h * 64);
}
__device__ __forceinline__ void pool_task(const Frame& F, int task, int l) {
    const int lane = F.lane, r32 = lane & 31, hi = lane >> 5;
    const bf16* U = PTR(bf16, F_U); bf16* MIX = PTR(bf16, F_MIX);
    const float* pw = inp(F, 7) + (size_t)l * 4 * 64 * 64; const float* ps = inp(F, 8) + l * 256;
    const int t0 = task * 32, tok = t0 + r32, spos = tok & 4095;
#pragma unroll
    for (int g = 0; g < 4; ++g) {
        const int win = 2 << g; const int cnt = (spos + 1) < win ? (spos + 1) : win; const float ic = 1.0f / (float)cnt;
        f32x16 a0, a1;
#pragma unroll
        for (int r = 0; r < 16; ++r) { a0[r] = 0.f; a1[r] = 0.f; }
#pragma unroll
        for (int s = 0; s < 4; ++s) {
            const int cb = g * 64 + 16 * s + 8 * hi;
            const v4u own = *(const v4u*)(U + (size_t)tok * 256 + cb);
            float sum[8] = {bflo(own.x), bfhi(own.x), bflo(own.y), bfhi(own.y), bflo(own.z), bfhi(own.z), bflo(own.w), bfhi(own.w)};
            float me[8];
#pragma unroll
            for (int j = 0; j < 8; ++j) me[j] = sum[j];
#pragma unroll
            for (int jj = 1; jj < win; ++jj) if (jj < cnt) { const v4u x = *(const v4u*)(U + (size_t)(tok - jj) * 256 + cb);
                sum[0] += bflo(x.x); sum[1] += bfhi(x.x); sum[2] += bflo(x.y); sum[3] += bfhi(x.y); sum[4] += bflo(x.z); sum[5] += bfhi(x.z); sum[6] += bflo(x.w); sum[7] += bfhi(x.w); }
            u32x4 aw; aw.x = cvtpk(sum[0] * ic - me[0], sum[1] * ic - me[1]); aw.y = cvtpk(sum[2] * ic - me[2], sum[3] * ic - me[3]);
            aw.z = cvtpk(sum[4] * ic - me[4], sum[5] * ic - me[5]); aw.w = cvtpk(sum[6] * ic - me[6], sum[7] * ic - me[7]);
            const bf16x8 af = __builtin_bit_cast(bf16x8, aw);
#pragma unroll
            for (int dv = 0; dv < 2; ++dv) { const float* wp = pw + (size_t)(g * 64 + 16 * s + 8 * hi) * 64 + 32 * dv + r32;
                u32x4 bw; bw.x = cvtpk(wp[0], wp[64]); bw.y = cvtpk(wp[128], wp[192]); bw.z = cvtpk(wp[256], wp[320]); bw.w = cvtpk(wp[384], wp[448]);
                const bf16x8 bfg = __builtin_bit_cast(bf16x8, bw);
                if (dv == 0) a0 = __builtin_amdgcn_mfma_f32_32x32x16_bf16(af, bfg, a0, 0, 0, 0); else a1 = __builtin_amdgcn_mfma_f32_32x32x16_bf16(af, bfg, a1, 0, 0, 0); }
        }
        const float sc0 = ps[g * 64 + r32], sc1 = ps[g * 64 + 32 + r32];
#pragma unroll
        for (int r = 0; r < 16; ++r) { bf16* o = MIX + (size_t)(t0 + crow(r, hi)) * DM + 768 + g * 64 + r32;
            o[0] = (bf16)(cvtpk(a0[r] * sc0, 0.f) & 0xffffu); o[32] = (bf16)(cvtpk(a1[r] * sc1, 0.f) & 0xffffu); }
    }
}
}
__device__ __forceinline__ void phase_a3_fast(const Frame& F, int l) {
    const int v = (F.bid & 7) * 32 + (F.bid >> 3), pair = v >> 3, j = v & 7;
    attn::mla_unit(F, pair >> 3, pair & 7, j);
    attn::mla_unit(F, pair >> 3, pair & 7, 15 - j);
    attn::sb_task(F, F.gw);
    if ((F.gw & 3) == 0) attn::pool_task(F, F.gw >> 2, l);
}

#ifndef FAST_A1
#define FAST_A1 1
#endif
#ifndef FAST_A2
#define FAST_A2 1
#endif
#ifndef FAST_A4
#define FAST_A4 1
#endif
#ifndef FAST_M3
#define FAST_M3 1
#endif
#ifndef FAST_M4
#define FAST_M4 1
#endif
__device__ __forceinline__ void phase_a1_fast(const Frame& F, int l) {
    using namespace pg8; const int bid = F.bid;
    { Gemm g{PTR(bf16, F_XB), wl(F, l, WO_IN), NTOK, 1280, 1024}; StaticOrder S; S.init(NTOK, 1280, 256, bid);
      EpiA1 E{SMALLP(float, SM_RINV), PTR(float, WS_ROPE), PTR(bf16, F_CQ), PTR(bf16, F_CKVX), PTR(bf16, F_KR), PTR(bf16, F_U), PTR(bf16, F_SBQ), PTR(bf16, F_SBK), SMALLP(float, SM_SSQQ), SMALLP(float, SM_SSQKV)};
      gemm_phase<EpiA1, StaticOrder, true, false>(F.lds, g, S, E, nullptr); }
    { Gemm g{wl(F, l, WO_IN) + (size_t)1280 * 1024, PTR(bf16, F_XB), 256, NTOK, 1024}; StaticOrder S; S.init(256, NTOK, 256, (bid + 192) & 255);
      EpiVT E{PTR(bf16, F_SBVT), SMALLP(float, SM_RINV), 0};
      gemm_phase<EpiVT, StaticOrder, true, false>(F.lds, g, S, E, nullptr); }
}
__device__ __forceinline__ void phase_a2_fast(const Frame& F, int l) {
    using namespace pg8; const int bid = F.bid;
    { Gemm g{PTR(bf16, F_CQ), wl(F, l, WO_UQ), NTOK, 768, 256}; StaticOrder S; S.init(NTOK, 768, 256, bid);
      EpiQ E{SMALLP(float, SM_SSQQ), PTR(float, WS_ROPE), PTR(bf16, F_Q)};
      gemm_phase<EpiQ, StaticOrder, true, false>(F.lds, g, S, E, nullptr); }
    { Gemm g{PTR(bf16, F_CKVX), wl(F, l, WO_UKV), NTOK, 512, 256}; StaticOrder S; S.init(NTOK, 512, 256, (bid + 64) & 255);
      EpiKN E{SMALLP(float, SM_SSQKV), PTR(bf16, F_KN)};
      gemm_phase<EpiKN, StaticOrder, true, false>(F.lds, g, S, E, nullptr); }
    { Gemm g{wl(F, l, WO_UKV) + (size_t)512 * 256, PTR(bf16, F_CKVX), 512, NTOK, 256}; StaticOrder S; S.init(512, NTOK, 256, (bid + 192) & 255);
      EpiVT E{PTR(bf16, F_VT), SMALLP(float, SM_SSQKV), 1};
      gemm_phase<EpiVT, StaticOrder, true, false>(F.lds, g, S, E, nullptr); }
}
__device__ __forceinline__ void phase_a4_fast(const Frame& F, int l) {
    using namespace pg8;
    Gemm g{PTR(bf16, F_MIX), wl(F, l, WO_OUT), NTOK, DM, DM}; StaticOrder S; S.init(NTOK, DM, 256, F.bid);
    EpiOut E{l == 0 ? inp(F, 0) : F.X, F.X, PTR(bf16, F_XB)};
    gemm_phase<EpiOut, StaticOrder, true, false>(F.lds, g, S, E, nullptr);
}
__device__ __forceinline__ void phase_m3_fast(const Frame& F, int l) {
    using namespace pg8;
    moe_offsets(F, l);
    const LAS int* off = (const LAS int*)(F.lds + LDS_TAB);
    MoeOrder S{off[32] >> 8, 2, 256, F.bid, (const LAS int*)(F.lds + LDS_TAB + 512)};
    Gemm g{PTR(bf16, F_XB), wl(F, l, WO_GU), 0, 0, DM};
    EpiGU E{SMALLP(float, SM_ROWR2), SMALLP(float, SM_ROWC), PTR(bf16, F_H)};
    gemm_phase<EpiGU, MoeOrder, true, true>(F.lds, g, S, E, SMALLP(int, SM_ROWTOK));
}
__device__ __forceinline__ void phase_m4_fast(const Frame& F, int l) {
    using namespace pg8;
    moe_offsets(F, l);
    const LAS int* off = (const LAS int*)(F.lds + LDS_TAB);
    MoeOrder S{off[32] >> 8, 4, 256, F.bid, (const LAS int*)(F.lds + LDS_TAB + 512)};
    Gemm g{PTR(bf16, F_H), wl(F, l, WO_D), 0, 0, DE};
    EpiY E{PTR(bf16, F_Y)};
    gemm_phase<EpiY, MoeOrder, true, false>(F.lds, g, S, E, nullptr);
}

constexpr int N_PHASES = 1 + 9 * DEPTH;
struct Args { const float* in[19]; float* out; unsigned char* ws; int ph_lo, ph_hi, li, pad; };
__global__ void __launch_bounds__(NTHREADS, 2) mk_fwd(Args args) {
    extern __shared__ __attribute__((aligned(16))) unsigned char lds[];
    Frame F;
    F.lds = (LAS unsigned char*)lds;
    F.tid = threadIdx.x; F.lane = F.tid & 63; F.wave = __builtin_amdgcn_readfirstlane(F.tid >> 6);
    F.gtid = blockIdx.x * NTHREADS + F.tid; F.gw = blockIdx.x * NWAVES + F.wave; F.bid = blockIdx.x;
    if (F.tid == 0) {
#pragma unroll
        for (int i = 0; i < 19; ++i) ((LAS unsigned long long*)(F.lds + PARAM_OFF))[i] = (unsigned long long)args.in[i];
    }
    F.X = args.out; F.ws = args.ws; F.ctl = (unsigned*)(args.ws + WS_CTL);
    volatile LAS unsigned* MISC = (volatile LAS unsigned*)(F.lds + MISC_OFF);
    if (F.tid < 32) MISC[F.tid] = 0u;
    __syncthreads();
    XcdBarrier bar; bar.bar = F.ctl + CW_BAR; bar.x = 0; bar.st = nullptr;
    if (MK_N_LAUNCHES == 1) bar = xcd_barrier_post(F.ctl + CW_BAR, MISC + 8);
    const int lo = args.ph_lo, hi = args.ph_hi;
#define PH_ENTER() do { int t_ = threadIdx.x, b_ = blockIdx.x; asm volatile("" : "+v"(t_)); asm volatile("" : "+s"(b_)); F.tid = t_; F.lane = t_ & 63; F.bid = b_; F.gtid = b_ * NTHREADS + t_; \
        F.wave = __builtin_amdgcn_readfirstlane(t_ >> 6); F.gw = b_ * NWAVES + F.wave; F.X = args.out; F.ws = args.ws; F.ctl = (unsigned*)(args.ws + WS_CTL); \
        asm volatile("" : "+s"(F.ws), "+s"(F.X), "+s"(F.ctl)); } while (0)
#define RUNPH(k, call) do { if (lo <= (k) && (k) < hi) { PH_ENTER(); call; if ((k) + 1 < hi) { bar.bar = F.ctl + CW_BAR; xcd_barrier(bar); } } } while (0)
#define LAYER(l) do { \
        RUNPH(1 + 9 * (l) + 0, if (FAST_A1) phase_a1_fast(F, l); else phase_a1(F, l)); \
        RUNPH(1 + 9 * (l) + 1, if (FAST_A2) phase_a2_fast(F, l); else phase_a2(F, l)); \
        RUNPH(1 + 9 * (l) + 2, if (FAST_A3) phase_a3_fast(F, l); else phase_a3(F, l)); \
        RUNPH(1 + 9 * (l) + 3, if (FAST_A4) phase_a4_fast(F, l); else phase_a4(F, l)); \
        RUNPH(1 + 9 * (l) + 4, phase_m1(F, l)); \
        RUNPH(1 + 9 * (l) + 5, phase_m2(F, l)); \
        RUNPH(1 + 9 * (l) + 6, if (FAST_M3) phase_m3_fast(F, l); else phase_m3(F, l)); \
        RUNPH(1 + 9 * (l) + 7, if (FAST_M4) phase_m4_fast(F, l); else phase_m4(F, l)); \
        RUNPH(1 + 9 * (l) + 8, phase_m5(F, l)); } while (0)
    RUNPH(0, phase_p0(F));
    LAYER(0);
    LAYER(1);
#undef LAYER
#undef RUNPH
#undef PH_ENTER
}

extern "C" void kernel_launch(void* const* d_in, const int* in_sizes, int n_in, void* d_out, int out_size, void* d_ws, size_t ws_size, hipStream_t stream) {
    static int ok = 0;
    if (ok == 0) {
        ok = 1;
        if (n_in != 19 || out_size != NTOK * DM || ws_size < F_END) { fprintf(stderr, "kernel_launch: unexpected shapes (n_in %d out %d ws %zu need %zu)\n", n_in, out_size, ws_size, (size_t)F_END); ok = -1; }
        if (hipFuncSetAttribute((const void*)mk_fwd, hipFuncAttributeMaxDynamicSharedMemorySize, LDS_BYTES) != hipSuccess) { fprintf(stderr, "kernel_launch: hipFuncSetAttribute failed\n"); ok = -1; }
    }
    if (ok < 0) return;
    (void)hipMemsetAsync((char*)d_ws + WS_CTL, 0, CTL_ZERO_BYTES, stream);
    Args a{};
    for (int i = 0; i < 19; ++i) a.in[i] = (const float*)d_in[i];
    a.out = (float*)d_out; a.ws = (unsigned char*)d_ws;
    if (MK_N_LAUNCHES == 1) { a.ph_lo = 0; a.ph_hi = N_PHASES; a.li = 0; hipLaunchKernelGGL(mk_fwd, dim3(256), dim3(NTHREADS), LDS_BYTES, stream, a); }
    else for (int p = 0; p < N_PHASES; ++p) { a.ph_lo = p; a.ph_hi = p + 1; a.li = p; hipLaunchKernelGGL(mk_fwd, dim3(256), dim3(NTHREADS), LDS_BYTES, stream, a); }
}
```

```cpp
#include <hip/hip_runtime.h>
#include <cstdio>
#include <cstdint>

#ifndef MK_N_LAUNCHES
#define MK_N_LAUNCHES 1
#endif

#define GAS __attribute__((address_space(1)))
#define LAS __attribute__((address_space(3)))
typedef unsigned short bf16;
typedef unsigned v4u __attribute__((ext_vector_type(4)));
typedef float f32x4 __attribute__((ext_vector_type(4)));
typedef GAS unsigned gu32;
#define RLX_AGENT __ATOMIC_RELAXED, __HIP_MEMORY_SCOPE_AGENT
#define LDS_WAIT() asm volatile("s_waitcnt lgkmcnt(0)" ::: "memory")

constexpr int DM = 1024, NBATCH = 4, SEQ = 4096, NTOK = NBATCH * SEQ, DEPTH = 2;
constexpr int AH = 8, AQL = 256, AKVL = 128;
constexpr int BHD = 4;
constexpr int DIN = 1440, NPAD = 1536;
constexpr int NEXP = 32, DE = 256;
constexpr float EPS = 1e-6f;
constexpr float LOG2E = 1.4426950408889634f;
constexpr float QSCALE_A = 0.10206207261596575f * LOG2E;
constexpr float QSCALE_B = 0.125f * LOG2E;
constexpr int NWAVES = 8, NTHREADS = 512;
constexpr int RMAX = 40960;

constexpr size_t MiB = 1u << 20;
constexpr size_t WS_CTL = 0, CTL_ZERO_BYTES = 256 * 1024;
constexpr size_t WS_ROPE = 512 * 1024;
constexpr size_t WS_WR = 1 * MiB;
constexpr size_t WO_IN = 0, WO_UQ = 1572864, WO_UKV = WO_UQ + 196608, WO_OUT = WO_UKV + 262144, WO_GU = WO_OUT + 1048576, WO_D = WO_GU + 16777216, WO_END = WO_D + 8388608;
constexpr size_t WL_BYTES = WO_END * 2;
constexpr size_t P_W = 2 * MiB;
constexpr size_t SM_RINV = 0, SM_R2 = 65536, SM_RTE = 131072, SM_RTPOS = 262144, SM_RTC = 393216, SM_TROW = 524288, SM_SSQQ = 655360, SM_SSQKV = 917504,
                 SM_ROWR2 = 1179648, SM_ROWC = 1343488, SM_ROWTOK = 1507328, SM_END = 1671168;
static_assert(SM_END <= 2 * MiB, "small");
constexpr size_t F_XB = 110 * MiB, F_SMALL = 142 * MiB, F_KR = 144 * MiB, F_U = 145 * MiB, F_SBQ = 153 * MiB, F_SBK = 161 * MiB, F_SBVT = 169 * MiB,
                 F_Q = 177 * MiB, F_KN = 201 * MiB, F_VT = 217 * MiB, F_CQ = 233 * MiB, F_CKVX = 241 * MiB, F_MIX = 233 * MiB, F_END = 265 * MiB;
constexpr size_t F_H = 144 * MiB, F_Y = 164 * MiB;
static_assert(F_Y + (size_t)RMAX * 1024 * 2 <= F_END, "moe overlay");
static_assert(P_W + 2 * WL_BYTES <= F_XB, "weights fit");

constexpr int CW_BAR = 1024;
constexpr int CW_CNT = 8192;

constexpr int LDS_BYTES = 147456;
constexpr int CTRL_BASE = 147456 - 4096;
constexpr int MISC_OFF = CTRL_BASE;

__device__ __forceinline__ float bf2f(bf16 v) { return __uint_as_float(((unsigned)v) << 16); }
__device__ __forceinline__ float bflo(unsigned w) { return __uint_as_float(w << 16); }
__device__ __forceinline__ float bfhi(unsigned w) { return __uint_as_float(w & 0xffff0000u); }
__device__ __forceinline__ unsigned f2bf(float f) { unsigned u = __float_as_uint(f); return (u + 0x7fffu + ((u >> 16) & 1u)) >> 16; }
__device__ __forceinline__ unsigned pk2(float lo, float hi) { return f2bf(lo) | (f2bf(hi) << 16); }
__device__ __forceinline__ float wave_sum(float v) {
#pragma unroll
    for (int o = 1; o < 64; o <<= 1) v += __shfl_xor(v, o);
    return v;
}
__device__ __forceinline__ int perm16(int t) { return (t & ~15) | (t & 3) | ((t & 8) >> 1) | ((t & 4) << 1); }
__device__ __forceinline__ size_t idx_KR(int b, int s, int i) { return ((((size_t)b * 64 + (s >> 6)) * 4 + (i >> 3)) * 64 + (s & 63)) * 8 + (i & 7); }
__device__ __forceinline__ size_t idx_KN(int b, int h, int s, int d) { return (((((size_t)b * 8 + h) * 64 + (s >> 6)) * 8 + (d >> 3)) * 64 + (s & 63)) * 8 + (d & 7); }
__device__ __forceinline__ size_t idx_Q(int b, int h, int s, int d) { return (((size_t)b * 8 + h) * SEQ + s) * 96 + d; }
__device__ __forceinline__ size_t idx_SB(int b, int h, int s, int d) { return (((size_t)b * 4 + h) * SEQ + s) * 64 + d; }

__device__ __forceinline__ float dot_bf16(const bf16* a, const bf16* b, int n) {
    float acc = 0.f;
    for (int k = 0; k < n; k += 8) {
        const v4u x = *(const v4u*)(a + k), y = *(const v4u*)(b + k);
        acc += bflo(x.x) * bflo(y.x) + bfhi(x.x) * bfhi(y.x) + bflo(x.y) * bflo(y.y) + bfhi(x.y) * bfhi(y.y)
             + bflo(x.z) * bflo(y.z) + bfhi(x.z) * bfhi(y.z) + bflo(x.w) * bflo(y.w) + bfhi(x.w) * bfhi(y.w);
    }
    return acc;
}

#define XB_TMO      128
#define XB_XCNT(j)  (256  + 64 * (j))
#define XB_XSUB(j)  (1280 + 64 * (j))
#define XB_XGEN(j)  (2304 + 64 * (j))
#define XB_TOP      3328
#define XB_TOPGEN   3392
#define XCD_BAR_WORDS 3456
#define XB_SPIN_CAP (1u << 22)
__device__ __forceinline__ unsigned xb_ld(unsigned* p)              { return __hip_atomic_load(p, __ATOMIC_RELAXED, __HIP_MEMORY_SCOPE_AGENT); }
__device__ __forceinline__ unsigned xb_add(unsigned* p, unsigned v) { return __hip_atomic_fetch_add(p, v, __ATOMIC_RELAXED, __HIP_MEMORY_SCOPE_AGENT); }
__device__ __forceinline__ unsigned xb_xcc_id() { return (unsigned)__builtin_amdgcn_s_getreg((3 << 11) | 20) & 0xFu; }
#define XB_SPIN(cond, bar) do { unsigned _sp = 0; while (cond) { __builtin_amdgcn_s_sleep(1); \
    if ((++_sp & 255u) == 0u) { if (xb_ld(&(bar)[XB_TMO])) break; if (_sp > XB_SPIN_CAP) { atomicAdd(&(bar)[XB_TMO], 1u); break; } } } } while (0)
struct XcdBarrier { unsigned* bar; unsigned x; volatile LAS unsigned* st; };
__device__ __forceinline__ XcdBarrier xcd_barrier_post(unsigned* bar, volatile LAS unsigned* st) {
    XcdBarrier b; b.bar = bar; b.x = xb_xcc_id(); b.st = st;
    if (threadIdx.x == 0) (void)xb_add(&bar[XB_XCNT(b.x)], 1u);
    return b;
}
__device__ __forceinline__ void xcd_barrier_complete(unsigned* bar, unsigned x, unsigned& nloc, unsigned& nx) {
    const unsigned G = gridDim.x * gridDim.y * gridDim.z;
    unsigned sum, cnt, mine, sp = 0u;
    for (;;) {
        sum = 0u; cnt = 0u; mine = 0u;
#pragma unroll
        for (unsigned j = 0; j < 16; ++j) { const unsigned c = xb_ld(&bar[XB_XCNT(j)]); sum += c; cnt += (c > 0u) ? 1u : 0u; mine = (j == x) ? c : mine; }
        if (sum == G) break;
        __builtin_amdgcn_s_sleep(1);
        if ((++sp & 255u) == 0u) { if (xb_ld(&bar[XB_TMO])) break; if (sp > XB_SPIN_CAP) { atomicAdd(&bar[XB_TMO], 1u); break; } }
    }
    nloc = mine > 0u ? mine : 1u; nx = cnt > 0u ? cnt : 1u;
}
__device__ __forceinline__ void xcd_barrier(const XcdBarrier& b) {
    asm volatile("s_waitcnt vmcnt(0)" ::: "memory");
    __syncthreads();
    if (threadIdx.x == 0) {
        unsigned* bar = b.bar;
        __builtin_amdgcn_s_waitcnt(0);
        unsigned nloc = b.st[0], nx = b.st[1];
        if (nloc == 0u) { xcd_barrier_complete(bar, b.x, nloc, nx); b.st[0] = nloc; b.st[1] = nx; }
        const unsigned old = xb_add(&bar[XB_XSUB(b.x)], 1u);
        const unsigned gen = old / nloc;
        if (old + 1u == (gen + 1u) * nloc) {
            __builtin_amdgcn_fence(__ATOMIC_RELEASE, "agent");
            asm volatile("s_waitcnt vmcnt(0)" ::: "memory");
            const unsigned og = xb_add(&bar[XB_TOP], 1u);
            const unsigned tg = og / nx;
            if (og + 1u == (tg + 1u) * nx) xb_add(&bar[XB_TOPGEN], 1u);
            else XB_SPIN(xb_ld(&bar[XB_TOPGEN]) == tg, bar);
            __builtin_amdgcn_fence(__ATOMIC_ACQUIRE, "agent");
            xb_add(&bar[XB_XGEN(b.x)], 1u);
            asm volatile("s_waitcnt vmcnt(0)" ::: "memory");
        } else {
            XB_SPIN(xb_ld(&bar[XB_XGEN(b.x)]) == gen, bar);
            __builtin_amdgcn_fence(__ATOMIC_ACQUIRE, "agent");
            asm volatile("s_waitcnt vmcnt(0)" ::: "memory");
        }
    }
    __syncthreads();
}


namespace pg8 {
typedef unsigned short bf16_t;
typedef short bf16x8 __attribute__((ext_vector_type(8)));
typedef unsigned u32x4 __attribute__((ext_vector_type(4)));
typedef unsigned u32x2 __attribute__((ext_vector_type(2)));
constexpr int BM = 256, BK = 64, HALF = 128, HTB = HALF * BK * 2, STAGE_BYTES = 8 * HTB, NXCD = 8, WGM = 8;
__host__ __device__ __forceinline__ int lds_byte(int r, int c) { const int st = (r >> 4) * 2 + (c >> 5), rr = r & 15, cc = c & 31, ob = rr * 64 + cc * 2; return st * 1024 + (ob ^ (((ob >> 9) & 1) << 5)); }
__host__ __device__ __forceinline__ void stage_rc(int b, int& R, int& C) { const int st = b / 1024, sb = b % 1024, swz = sb ^ (((sb >> 9) & 1) << 5); R = (st >> 1) * 16 + swz / 64; C = (st & 1) * 32 + (swz % 64) / 2; }
__host__ __device__ __forceinline__ int perm32(int rho) { const int n = rho >> 4, i = rho & 15; return 8 * (i >> 2) + 4 * n + (i & 3); }
struct Unit { int pm, pn; };
struct Gemm { const bf16_t* A; const bf16_t* Bt; int M, N, K; };
struct StaticOrder {
    int nM, nN, nwg, G, c;
    __device__ void init(int M, int N, int G_, int c_) { nM = M / BM; nN = N / BM; nwg = nM * nN; G = G_; c = c_; }
    __device__ bool next(int i, Unit& u) const {
        const long L = (long)i * G + c; if (L >= nwg) return false;
        int wgid = (int)L; { const int q = nwg / NXCD, r = nwg % NXCD, xcd = wgid % NXCD, off = wgid / NXCD; wgid = (xcd < r ? xcd * (q + 1) : r * (q + 1) + (xcd - r) * q) + off; }
        const int nig = WGM * nN, gid = wgid / nig, fm = gid * WGM, gsz = (nM - fm) < WGM ? (nM - fm) : WGM;
        u.pm = fm + ((wgid % nig) % gsz); u.pn = (wgid % nig) / gsz; return true;
    }
};
struct MoeOrder {
    int ntiles, npn, G, c; const LAS int* tile_e;
    __device__ bool next(int i, Unit& u) const {
        const int L = i * G + c; if (L >= ntiles * npn) return false;
        const int tile = L / npn, pnl = L % npn; u.pm = tile; u.pn = tile_e[tile] * npn + pnl; return true;
    }
};
__device__ __forceinline__ unsigned cvt_pk_bf16(float lo, float hi) { unsigned r; asm volatile("v_cvt_pk_bf16_f32 %0, %1, %2" : "=v"(r) : "v"(lo), "v"(hi)); return r; }
__device__ __forceinline__ u32x4 pack8(const f32x4 a, const f32x4 b) { u32x4 w; w.x = cvt_pk_bf16(a[0], a[1]); w.y = cvt_pk_bf16(a[2], a[3]); w.z = cvt_pk_bf16(b[0], b[1]); w.w = cvt_pk_bf16(b[2], b[3]); return w; }
__device__ __forceinline__ u32x2 pack4(const f32x4 a) { u32x2 w; w.x = cvt_pk_bf16(a[0], a[1]); w.y = cvt_pk_bf16(a[2], a[3]); return w; }

template <class Epi, class Sched, bool ALIGN_EPI, bool GATHER>
__device__ __forceinline__ void gemm_phase(LAS unsigned char* lds, const Gemm g, const Sched& S, const Epi& E, const int* rowtok) {
    const int tid = threadIdx.x, wid = __builtin_amdgcn_readfirstlane(tid >> 6), lane = tid & 63, wr = wid >> 2, wc = wid & 3, fr = lane & 15, fq = lane >> 4;
    const int K = g.K, nt = K / BK;
    const size_t kstep = (size_t)(BK * 2);
    const size_t hstep = (size_t)HALF * K * 2;
    const size_t tstep = 2 * hstep;
    int RA[2], CA[2]; unsigned voffB[2], voffA[2], cv0[2], cv1[2], nv0[2], nv1[2];
#pragma unroll
    for (int i = 0; i < 2; ++i) { int R, C; stage_rc(tid * 16 + i * 8192, R, C); const int Rb = (R & ~31) + perm32(R & 31);
        RA[i] = R; CA[i] = C; voffB[i] = (unsigned)(Rb * K + C) * 2u; voffA[i] = (unsigned)(R * K + C) * 2u; cv0[i] = 0u; cv1[i] = 0u; nv0[i] = 0u; nv1[i] = 0u; }
    const unsigned ldsw = (unsigned)wid * 1024u;
    const int aoff = lds_byte(wr * 64 + fr, fq * 8), boff = lds_byte(wc * 32 + fr, fq * 8);
#define PG8_SA(b, h) (((b) * 2 + (h)) * HTB)
#define PG8_SB(b, h) ((4 + (b) * 2 + (h)) * HTB)
#define PG8_STAGE(bufoff, gbase, voff) do { _Pragma("unroll") for (int _i = 0; _i < 2; ++_i) \
        __builtin_amdgcn_global_load_lds((const unsigned*)((const char*)(gbase) + (voff)[_i]), (LAS unsigned*)(lds + (bufoff) + ldsw + _i * 8192), 16, 0, 0); } while (0)
#define PG8_STAGE_A(bufoff, gbase, half, V0, V1) do { if constexpr (GATHER) { if (half) PG8_STAGE(bufoff, gbase, V1); else PG8_STAGE(bufoff, gbase, V0); } \
        else { PG8_STAGE(bufoff, (gbase) + (half) * hstep, voffA); } } while (0)
#define PG8_LDA(dst, b, h) do { _Pragma("unroll") for (int m = 0; m < 4; ++m) _Pragma("unroll") for (int k = 0; k < 2; ++k) dst[m][k] = *(const LAS bf16x8*)(lds + PG8_SA(b, h) + aoff + m * 2048 + k * 1024); } while (0)
#define PG8_LDB(dst, b, h) do { _Pragma("unroll") for (int n = 0; n < 2; ++n) _Pragma("unroll") for (int k = 0; k < 2; ++k) dst[n][k] = *(const LAS bf16x8*)(lds + PG8_SB(b, h) + boff + n * 2048 + k * 1024); } while (0)
#define PG8_MMA(ai, bj, At, Bt) do { __builtin_amdgcn_s_setprio(1); _Pragma("unroll") for (int m = 0; m < 4; ++m) _Pragma("unroll") for (int n = 0; n < 2; ++n) _Pragma("unroll") for (int k = 0; k < 2; ++k) \
        acc[ai][bj][m][n] = __builtin_amdgcn_mfma_f32_16x16x32_bf16(Bt[n][k], At[m][k], acc[ai][bj][m][n], 0, 0, 0); __builtin_amdgcn_s_setprio(0); } while (0)
#define PG8_WAIT_V(n) asm volatile("s_waitcnt vmcnt(" #n ")" ::: "memory")
#define PG8_WAIT_L(n) asm volatile("s_waitcnt lgkmcnt(" #n ")" ::: "memory")
#define PG8_BAR __builtin_amdgcn_s_barrier()
#define PG8_SCHED __builtin_amdgcn_sched_barrier(0)
#define PG8_GVOFF(U, V0, V1) do { if constexpr (GATHER) { _Pragma("unroll") for (int _i = 0; _i < 2; ++_i) { \
        const unsigned t0_ = (unsigned)rowtok[(U).pm * BM + RA[_i]], t1_ = (unsigned)rowtok[(U).pm * BM + HALF + RA[_i]]; \
        V0[_i] = (t0_ * (unsigned)K + (unsigned)CA[_i]) * 2u; V1[_i] = (t1_ * (unsigned)K + (unsigned)CA[_i]) * 2u; } \
        asm volatile("s_waitcnt vmcnt(0)" ::: "memory"); } } while (0)
    Unit cur, nxt; int ui = 0;
    if (!S.next(0, cur)) return;
    f32x4 acc[2][2][4][2];
#pragma unroll
    for (int a = 0; a < 2; ++a)
#pragma unroll
        for (int b = 0; b < 2; ++b)
#pragma unroll
            for (int m = 0; m < 4; ++m)
#pragma unroll
                for (int n = 0; n < 2; ++n) acc[a][b][m][n] = (f32x4){0.f, 0.f, 0.f, 0.f};
    bf16x8 At[4][2], B0[2][2], B1[2][2];
    const char* cA = GATHER ? (const char*)g.A : (const char*)g.A + (size_t)cur.pm * tstep; const char* cB = (const char*)g.Bt + (size_t)cur.pn * tstep;
    PG8_GVOFF(cur, cv0, cv1);
    PG8_STAGE(PG8_SB(0, 0), cB, voffB); PG8_STAGE(PG8_SB(0, 1), cB + hstep, voffB); PG8_STAGE_A(PG8_SA(0, 0), cA, 0, cv0, cv1); PG8_STAGE_A(PG8_SA(0, 1), cA, 1, cv0, cv1);
    if (wr == 1) PG8_BAR;
    PG8_WAIT_V(2); PG8_BAR;
    PG8_STAGE(PG8_SB(1, 0), cB + kstep, voffB); PG8_STAGE_A(PG8_SA(1, 0), cA + kstep, 0, cv0, cv1); PG8_STAGE(PG8_SB(1, 1), cB + hstep + kstep, voffB);
    PG8_WAIT_V(6); PG8_BAR;
    for (;;) {
        const bool has_next = S.next(ui + 1, nxt);
        const char* nA = GATHER ? (const char*)g.A : (has_next ? (const char*)g.A + (size_t)nxt.pm * tstep : cA); const char* nB = has_next ? (const char*)g.Bt + (size_t)nxt.pn * tstep : cB;
        if constexpr (GATHER) { if (has_next) { PG8_GVOFF(nxt, nv0, nv1); } else { nv0[0] = cv0[0]; nv0[1] = cv0[1]; nv1[0] = cv1[0]; nv1[1] = cv1[1]; } }
#pragma unroll 1
        for (int t = 0; t < nt; t += 2) {
            const bool last = (t == nt - 2);
            const char* a1 = cA + (size_t)(t + 1) * kstep;
            const char* a2 = last ? nA : cA + (size_t)(t + 2) * kstep; const char* b2 = last ? nB : cB + (size_t)(t + 2) * kstep;
            const char* a3 = a2 + kstep; const char* b3 = b2 + kstep;
            unsigned va0[2] = {0u, 0u}, va1[2] = {0u, 0u};
            if constexpr (GATHER) { va0[0] = last ? nv0[0] : cv0[0]; va0[1] = last ? nv0[1] : cv0[1]; va1[0] = last ? nv1[0] : cv1[0]; va1[1] = last ? nv1[1] : cv1[1]; }
            PG8_LDB(B0, 0, 0); PG8_LDB(B1, 0, 1); PG8_SCHED; PG8_LDA(At, 0, 0); PG8_STAGE_A(PG8_SA(1, 1), a1, 1, cv0, cv1);
            PG8_WAIT_V(8); PG8_WAIT_L(0); PG8_BAR; PG8_MMA(0, 0, At, B0); PG8_MMA(0, 1, At, B1); PG8_BAR; PG8_SCHED;
            PG8_LDA(At, 0, 1); PG8_STAGE(PG8_SB(0, 0), b2, voffB); PG8_STAGE(PG8_SB(0, 1), b2 + hstep, voffB); PG8_STAGE_A(PG8_SA(0, 0), a2, 0, va0, va1);
            PG8_WAIT_V(8); PG8_WAIT_L(0); PG8_BAR; PG8_MMA(1, 0, At, B0); PG8_MMA(1, 1, At, B1); PG8_BAR; PG8_SCHED;
            PG8_LDB(B0, 1, 0); PG8_LDB(B1, 1, 1); PG8_SCHED; PG8_LDA(At, 1, 0); PG8_STAGE_A(PG8_SA(0, 1), a2, 1, va0, va1);
            PG8_WAIT_V(8); PG8_WAIT_L(0); PG8_BAR; PG8_MMA(0, 0, At, B0); PG8_MMA(0, 1, At, B1); PG8_BAR; PG8_SCHED;
            PG8_LDA(At, 1, 1); PG8_STAGE(PG8_SB(1, 0), b3, voffB); PG8_STAGE(PG8_SB(1, 1), b3 + hstep, voffB); PG8_STAGE_A(PG8_SA(1, 0), a3, 0, va0, va1);
            PG8_WAIT_V(8); PG8_WAIT_L(0); PG8_BAR; PG8_MMA(1, 0, At, B0); PG8_MMA(1, 1, At, B1); PG8_BAR; PG8_SCHED;
        }
        if constexpr (ALIGN_EPI) { if (wr == 0) PG8_BAR; }
        E(acc, cur, wr, wc, fr, fq);
        if (!has_next) break;
#pragma unroll
        for (int a = 0; a < 2; ++a)
#pragma unroll
            for (int b = 0; b < 2; ++b)
#pragma unroll
                for (int m = 0; m < 4; ++m)
#pragma unroll
                    for (int n = 0; n < 2; ++n) acc[a][b][m][n] = (f32x4){0.f, 0.f, 0.f, 0.f};
        cur = nxt; cA = nA; cB = nB; ++ui;
        if constexpr (GATHER) { cv0[0] = nv0[0]; cv0[1] = nv0[1]; cv1[0] = nv1[0]; cv1[1] = nv1[1]; }
        if constexpr (ALIGN_EPI) { if (wr == 1) PG8_BAR; }
    }
    PG8_WAIT_V(0);
    if constexpr (!ALIGN_EPI) { if (wr == 0) PG8_BAR; }
    PG8_BAR;
#undef PG8_SA
#undef PG8_SB
#undef PG8_STAGE
#undef PG8_STAGE_A
#undef PG8_LDA
#undef PG8_LDB
#undef PG8_MMA
#undef PG8_WAIT_V
#undef PG8_WAIT_L
#undef PG8_BAR
#undef PG8_SCHED
#undef PG8_GVOFF
}

typedef f32x4 Acc[2][2][4][2];
#define EPI_ROWS(u) const int rowb_ = (u).pm * BM + wr * 64 + fr
struct EpiA1 {
    const float* rinv; const float* rope; bf16_t *CQ, *CKVX, *KR, *U, *SBQ, *SBK; float *SSQQ, *SSQKV;
    __device__ __forceinline__ void operator()(const Acc& acc, const Unit& u, int wr, int wc, int fr, int fq) const {
        EPI_ROWS(u); const int pn = u.pn;
#pragma unroll
        for (int ai = 0; ai < 2; ++ai)
#pragma unroll
            for (int m = 0; m < 4; ++m) {
                const int row = rowb_ + ai * HALF + m * 16; const float r = rinv[row]; const int b = row >> 12, s = row & 4095;
                float ssq = 0.f;
#pragma unroll
                for (int bj = 0; bj < 2; ++bj) {
                    const f32x4 v0 = acc[ai][bj][m][0] * r, v1 = acc[ai][bj][m][1] * r; const int col = bj * HALF + wc * 32 + 8 * fq;
                    if (pn <= 1) {
                        bf16_t* dst = (pn == 0 ? CQ : CKVX) + (size_t)row * 256 + col; *(u32x4*)dst = pack8(v0, v1);
                        if (pn == 0 || bj == 0) ssq += (v0[0] * v0[0] + v0[1] * v0[1]) + (v0[2] * v0[2] + v0[3] * v0[3]) + (v1[0] * v1[0] + v1[1] * v1[1]) + (v1[2] * v1[2] + v1[3] * v1[3]);
                        if (pn == 1 && bj == 1 && wc == 0) {
                            const f32x4 t0 = *(const f32x4*)(rope + (size_t)(s * 16 + 4 * fq) * 2), t1 = *(const f32x4*)(rope + (size_t)(s * 16 + 4 * fq) * 2 + 4);
                            const f32x4 cs = {t0[0], t0[2], t1[0], t1[2]}, sn = {t0[1], t0[3], t1[1], t1[3]};
                            const f32x4 o1 = v0 * cs - v1 * sn, o2 = v1 * cs + v0 * sn;
                            *(u32x2*)(KR + idx_KR(b, s, 4 * fq)) = pack4(o1); *(u32x2*)(KR + idx_KR(b, s, 16 + 4 * fq)) = pack4(o2); }
                    } else if (pn <= 3) {
                        const float sc = pn == 2 ? QSCALE_B : 1.0f;
                        *(u32x4*)((pn == 2 ? SBQ : SBK) + idx_SB(b, 2 * bj + (wc >> 1), s, 32 * (wc & 1) + 8 * fq)) = pack8(v0 * sc, v1 * sc);
                    } else { *(u32x4*)(U + (size_t)row * 256 + col) = pack8(v0, v1); }
                }
                if (pn <= 1) { ssq += __shfl_xor(ssq, 16); ssq += __shfl_xor(ssq, 32); if (fq == 0) (pn == 0 ? SSQQ : SSQKV)[row * 4 + wc] = ssq; }
                asm volatile("" ::: "memory");
            }
    }
};
struct EpiVT {
    bf16_t* VT; const float* sc; int mode;
    __device__ __forceinline__ void operator()(const Acc& acc, const Unit& u, int wr, int wc, int fr, int fq) const {
        EPI_ROWS(u);
#pragma unroll
        for (int bj = 0; bj < 2; ++bj) {
            const int t0 = u.pn * BM + bj * HALF + wc * 32 + 8 * fq; f32x4 s0, s1;
            if (mode == 0) { s0 = *(const f32x4*)(sc + t0); s1 = *(const f32x4*)(sc + t0 + 4); }
            else {
#pragma unroll
                for (int e = 0; e < 4; ++e) { const f32x4 p = *(const f32x4*)(sc + (size_t)(t0 + e) * 4), q = *(const f32x4*)(sc + (size_t)(t0 + 4 + e) * 4);
                    s0[e] = 1.0f / sqrtf(((p[0] + p[1]) + (p[2] + p[3])) * (1.0f / AKVL) + EPS); s1[e] = 1.0f / sqrtf(((q[0] + q[1]) + (q[2] + q[3])) * (1.0f / AKVL) + EPS); } }
            const int base16 = t0 & ~15, p0 = base16 + ((t0 & 8) ? 4 : 0), p1 = base16 + ((t0 & 8) ? 12 : 8);
#pragma unroll
            for (int ai = 0; ai < 2; ++ai)
#pragma unroll
                for (int m = 0; m < 4; ++m) { const int f = rowb_ + ai * HALF + m * 16;
                    *(u32x2*)(VT + (size_t)f * NTOK + p0) = pack4(acc[ai][bj][m][0] * s0); *(u32x2*)(VT + (size_t)f * NTOK + p1) = pack4(acc[ai][bj][m][1] * s1); }
        }
    }
};
struct EpiQ {
    const float* ssq; const float* rope; bf16_t* Q;
    __device__ __forceinline__ void operator()(const Acc& acc, const Unit& u, int wr, int wc, int fr, int fq) const {
        EPI_ROWS(u); const int pn = u.pn;
#pragma unroll
        for (int ai = 0; ai < 2; ++ai)
#pragma unroll
            for (int m = 0; m < 4; ++m) {
                const int row = rowb_ + ai * HALF + m * 16; const int b = row >> 12, s = row & 4095;
                const f32x4 p = *(const f32x4*)(ssq + (size_t)row * 4);
                const float r = QSCALE_A / sqrtf(((p[0] + p[1]) + (p[2] + p[3])) * (1.0f / AQL) + EPS);
#pragma unroll
                for (int bj = 0; bj < 2; ++bj) {
                    const f32x4 v0 = acc[ai][bj][m][0] * r, v1 = acc[ai][bj][m][1] * r;
                    if (pn < 2) { *(u32x4*)(Q + idx_Q(b, 4 * pn + 2 * bj + (wc >> 1), s, 32 * (wc & 1) + 8 * fq)) = pack8(v0, v1); }
                    else { const f32x4 t0 = *(const f32x4*)(rope + (size_t)(s * 16 + 4 * fq) * 2), t1 = *(const f32x4*)(rope + (size_t)(s * 16 + 4 * fq) * 2 + 4);
                        const f32x4 cs = {t0[0], t0[2], t1[0], t1[2]}, sn = {t0[1], t0[3], t1[1], t1[3]};
                        const f32x4 o1 = v0 * cs - v1 * sn, o2 = v1 * cs + v0 * sn; const int h = 4 * bj + wc;
                        *(u32x2*)(Q + idx_Q(b, h, s, 64 + 4 * fq)) = pack4(o1); *(u32x2*)(Q + idx_Q(b, h, s, 80 + 4 * fq)) = pack4(o2); }
                }
            }
    }
};
struct EpiKN {
    const float* ssq; bf16_t* KN;
    __device__ __forceinline__ void operator()(const Acc& acc, const Unit& u, int wr, int wc, int fr, int fq) const {
        EPI_ROWS(u); const int pn = u.pn;
#pragma unroll
        for (int ai = 0; ai < 2; ++ai)
#pragma unroll
            for (int m = 0; m < 4; ++m) {
                const int row = rowb_ + ai * HALF + m * 16; const int b = row >> 12, s = row & 4095;
                const f32x4 p = *(const f32x4*)(ssq + (size_t)row * 4);
                const float r = 1.0f / sqrtf(((p[0] + p[1]) + (p[2] + p[3])) * (1.0f / AKVL) + EPS);
#pragma unroll
                for (int bj = 0; bj < 2; ++bj)
                    *(u32x4*)(KN + idx_KN(b, 4 * pn + 2 * bj + (wc >> 1), s, 32 * (wc & 1) + 8 * fq)) = pack8(acc[ai][bj][m][0] * r, acc[ai][bj][m][1] * r);
            }
    }
};
struct EpiOut {
    const float* xin; float* X; bf16_t* XB;
    __device__ __forceinline__ void operator()(const Acc& acc, const Unit& u, int wr, int wc, int fr, int fq) const {
        EPI_ROWS(u);
#pragma unroll
        for (int ai = 0; ai < 2; ++ai)
#pragma unroll
            for (int m = 0; m < 4; ++m) {
                const int row = rowb_ + ai * HALF + m * 16;
#pragma unroll
                for (int bj = 0; bj < 2; ++bj) { const size_t o = (size_t)row * DM + u.pn * BM + bj * HALF + wc * 32 + 8 * fq;
                    const f32x4 v0 = *(const f32x4*)(xin + o) + acc[ai][bj][m][0], v1 = *(const f32x4*)(xin + o + 4) + acc[ai][bj][m][1];
                    *(f32x4*)(X + o) = v0; *(f32x4*)(X + o + 4) = v1; *(u32x4*)(XB + o) = pack8(v0, v1); }
            }
    }
};
struct EpiGU {
    const float* rowr2; const float* rowc; bf16_t* H;
    __device__ __forceinline__ void operator()(const Acc& acc, const Unit& u, int wr, int wc, int fr, int fq) const {
        EPI_ROWS(u); const int pnl = u.pn & 1;
#pragma unroll
        for (int ai = 0; ai < 2; ++ai)
#pragma unroll
            for (int m = 0; m < 4; ++m) {
                const int row = rowb_ + ai * HALF + m * 16; const float r2 = rowr2[row], c = rowc[row];
                f32x4 h[2];
#pragma unroll
                for (int n = 0; n < 2; ++n)
#pragma unroll
                    for (int e = 0; e < 4; ++e) { const float gt = acc[ai][0][m][n][e] * r2, up = acc[ai][1][m][n][e] * r2;
                        h[n][e] = gt * __builtin_amdgcn_rcpf(1.0f + __builtin_amdgcn_exp2f(-gt * LOG2E)) * up * c; }
                *(u32x4*)(H + (size_t)row * 256 + pnl * 128 + wc * 32 + 8 * fq) = pack8(h[0], h[1]);
            }
    }
};
struct EpiY {
    bf16_t* Y;
    __device__ __forceinline__ void operator()(const Acc& acc, const Unit& u, int wr, int wc, int fr, int fq) const {
        EPI_ROWS(u); const int pnl = u.pn & 3;
#pragma unroll
        for (int ai = 0; ai < 2; ++ai)
#pragma unroll
            for (int m = 0; m < 4; ++m) {
                const int row = rowb_ + ai * HALF + m * 16;
#pragma unroll
                for (int bj = 0; bj < 2; ++bj) *(u32x4*)(Y + (size_t)row * DM + pnl * BM + bj * HALF + wc * 32 + 8 * fq) = pack8(acc[ai][bj][m][0], acc[ai][bj][m][1]);
            }
    }
};
}

struct Frame {
    LAS unsigned char* lds;
    unsigned* ctl;
    int tid, lane, wave, gtid, gw, bid;
    float* X;
    unsigned char* ws;
};
constexpr int GT = 256 * NTHREADS, NGW = 256 * NWAVES;
constexpr int PARAM_OFF = CTRL_BASE + 256;
__device__ __forceinline__ const float* inp(const Frame& F, int k) {
    const unsigned long long v = ((const LAS unsigned long long*)(F.lds + PARAM_OFF))[k];
    const unsigned lo = __builtin_amdgcn_readfirstlane((unsigned)v), hi = __builtin_amdgcn_readfirstlane((unsigned)(v >> 32));
    return (const float*)(const GAS float*)(((unsigned long long)hi << 32) | lo);
}

__device__ __forceinline__ bf16* wl(const Frame& F, int l, size_t off) { return (bf16*)(F.ws + P_W + (size_t)l * WL_BYTES) + off; }
#define PTR(type, off) ((type*)(F.ws + (off)))
#define SMALLP(type, off) ((type*)(F.ws + F_SMALL + (off)))

__device__ __forceinline__ int rope_pos(int i) { return 8 * ((i >> 2) & 3) + 4 * (i >> 4) + (i & 3); }
__device__ __forceinline__ int rope_feat(int rho) { return 16 * ((rho >> 2) & 1) + 4 * (rho >> 3) + (rho & 3); }
constexpr int TSTR = 69;
__device__ __forceinline__ void transpose_item64(const float* W, int ldw, int k0, int c0, int ncols, bf16* WT, int ldt, int drow0, int drow1, bool rp0, bool rp1, const float* gain, LAS float* scr, int lane) {
    const int c4 = lane & 15, rq = lane >> 4; const bool act = 4 * c4 < ncols;
    f32x4 v[16]; float g[16];
#pragma unroll
    for (int i = 0; i < 16; ++i) { const int row = 4 * i + rq; v[i] = act ? *(const f32x4*)(W + (size_t)(k0 + row) * ldw + c0 + 4 * c4) : (f32x4){0.f, 0.f, 0.f, 0.f}; g[i] = gain ? gain[k0 + row] : 1.0f; }
#pragma unroll
    for (int i = 0; i < 16; ++i) { const int row = 4 * i + rq; LAS float* d = scr + row * TSTR + 4 * c4; d[0] = v[i][0] * g[i]; d[1] = v[i][1] * g[i]; d[2] = v[i][2] * g[i]; d[3] = v[i][3] * g[i]; }
    LDS_WAIT(); asm volatile("" ::: "memory");
    const int kc = lane & 7;
#pragma unroll
    for (int i = 0; i < 8; ++i) { const int n = 8 * i + (lane >> 3); const LAS float* s = scr + (8 * kc) * TSTR + n;
        v4u o; o.x = pk2(s[0 * TSTR], s[1 * TSTR]); o.y = pk2(s[2 * TSTR], s[3 * TSTR]); o.z = pk2(s[4 * TSTR], s[5 * TSTR]); o.w = pk2(s[6 * TSTR], s[7 * TSTR]);
        const int half = n >> 5, nn = n & 31; const int dr = (half ? drow1 : drow0) + ((half ? rp1 : rp0) ? rope_pos(nn) : nn);
        if (n < ncols) *(v4u*)(WT + (size_t)dr * ldt + k0 + 8 * kc) = o; }
    LDS_WAIT(); asm volatile("" ::: "memory");
}
__device__ __forceinline__ int in_drow(int c0) { return c0 < 416 ? c0 : c0 < 672 ? 512 + (c0 - 416) : c0 < 928 ? 768 + (c0 - 672) : c0 < 1184 ? 1280 + (c0 - 928) : 1024 + (c0 - 1184); }
__device__ __forceinline__ int uq_drow(int cb) { const int h = cb / 3, p = cb % 3; return p < 2 ? 64 * h + 32 * p : 512 + 32 * h; }
__device__ __forceinline__ int ukv_drow(int cb) { const int h = cb / 4, p = cb % 4; return p < 2 ? 64 * h + 32 * p : 512 + 64 * h + 32 * (p - 2); }
constexpr int IT_IN = 16 * 23, IT_UQ = 4 * 12, IT_UKV = 2 * 16, IT_OUT = 16 * 16, IT_G = 32 * 16 * 4, IT_D = 32 * 4 * 16;
constexpr int IT_LAYER = IT_IN + IT_UQ + IT_UKV + IT_OUT + 2 * IT_G + IT_D;
__device__ __forceinline__ void p0_item(const Frame& F, int it, LAS float* scr) {
    const int l = it / IT_LAYER; int r = it % IT_LAYER; const int lane = F.lane;
    if (r < IT_IN) { const int kb = r / 23, cp = r % 23, c0 = 64 * cp, nc = cp == 22 ? 32 : 64;
        transpose_item64(inp(F, 2) + (size_t)l * DM * DIN, DIN, 64 * kb, c0, nc, wl(F, l, WO_IN), 1024, in_drow(c0), in_drow(c0 + 32), c0 == 384, c0 + 32 == 384, inp(F, 1) + l * DM, scr, lane); return; } r -= IT_IN;
    if (r < IT_UQ) { const int kb = r / 12, cp = r % 12;
        transpose_item64(inp(F, 4) + (size_t)l * AQL * 768, 768, 64 * kb, 64 * cp, 64, wl(F, l, WO_UQ), 256, uq_drow(2 * cp), uq_drow(2 * cp + 1), (2 * cp) % 3 == 2, (2 * cp + 1) % 3 == 2, inp(F, 3) + l * AQL, scr, lane); return; } r -= IT_UQ;
    if (r < IT_UKV) { const int kb = r / 16, cp = r % 16;
        transpose_item64(inp(F, 6) + (size_t)l * AKVL * 1024, 1024, 64 * kb, 64 * cp, 64, wl(F, l, WO_UKV), 256, ukv_drow(2 * cp), ukv_drow(2 * cp + 1), false, false, inp(F, 5) + l * AKVL, scr, lane); return; } r -= IT_UKV;
    if (r < IT_OUT) { const int kb = r / 16, cp = r % 16;
        transpose_item64(inp(F, 9) + (size_t)l * DM * DM, DM, 64 * kb, 64 * cp, 64, wl(F, l, WO_OUT), 1024, 64 * cp, 64 * cp + 32, false, false, nullptr, scr, lane); return; } r -= IT_OUT;
    if (r < 2 * IT_G) { const int up = r / IT_G; r %= IT_G; const int e = r / 64, q = r % 64, kb = q / 4, cp = q % 4;
        const int d0 = e * 512 + 256 * (cp >> 1) + 64 * (cp & 1) + 128 * up;
        transpose_item64((up ? inp(F, 16) : inp(F, 15)) + ((size_t)l * NEXP + e) * DM * DE, DE, 64 * kb, 64 * cp, 64, wl(F, l, WO_GU), 1024, d0, d0 + 32, false, false, inp(F, 10) + l * DM, scr, lane); return; } r -= 2 * IT_G;
    { const int e = r / 64, q = r % 64, kb = q / 16, cp = q % 16;
        transpose_item64(inp(F, 17) + ((size_t)l * NEXP + e) * DE * DM, DM, 64 * kb, 64 * cp, 64, wl(F, l, WO_D), 256, e * 1024 + 64 * cp, e * 1024 + 64 * cp + 32, false, false, nullptr, scr, lane); }
}
__device__ __forceinline__ void row_to_bf16_rinv(const Frame& F, const float* xrow, bf16* orow, float* rinv) {
    const f32x4* xr = (const f32x4*)xrow + F.lane;
    f32x4 v[4]; float s = 0.f;
#pragma unroll
    for (int j = 0; j < 4; ++j) { v[j] = xr[64 * j]; s += (v[j].x * v[j].x + v[j].y * v[j].y) + (v[j].z * v[j].z + v[j].w * v[j].w); }
    s = wave_sum(s);
    if (F.lane == 0) *rinv = 1.0f / sqrtf(s * (1.0f / DM) + EPS);
    unsigned long long* o8 = (unsigned long long*)orow + F.lane;
#pragma unroll
    for (int j = 0; j < 4; ++j) o8[64 * j] = (unsigned long long)pk2(v[j].x, v[j].y) | ((unsigned long long)pk2(v[j].z, v[j].w) << 32);
}
__device__ __forceinline__ void phase_p0(const Frame& F) {
    LAS float* scr = (LAS float*)(F.lds + F.wave * (64 * TSTR * 4));
    for (int it = F.gw; it < DEPTH * IT_LAYER; it += NGW) p0_item(F, it, scr);
    for (int l = 0; l < DEPTH; ++l) {
        v4u z = {0u, 0u, 0u, 0u};
        for (int i = F.gtid; i < 96 * 1024 / 8; i += GT) *(v4u*)(wl(F, l, WO_IN) + (size_t)416 * 1024 + (size_t)i * 8) = z;
        for (int i = F.gtid; i < 1024 * 16; i += GT) { const int n = i >> 4, c = i & 15; *(v4u*)(wl(F, l, WO_UKV) + (size_t)n * 256 + 128 + c * 8) = z; }
        bf16* wh = PTR(bf16, WS_WR) + (size_t)l * 2 * 48 * 1024; bf16* wlo = wh + 48 * 1024;
        for (int i = F.gtid; i < 48 * 1024; i += GT) { const int j = i >> 10, k = i & 1023; float v = 0.f;
            if (j < 4) v = inp(F, 11)[((size_t)l * DM + k) * 4 + j]; else if (j < 36) v = inp(F, 13)[((size_t)l * DM + k) * 32 + (j - 4)];
            v *= inp(F, 10)[l * DM + k]; const unsigned h16 = f2bf(v); wh[i] = (bf16)h16; wlo[i] = (bf16)f2bf(v - __uint_as_float(h16 << 16)); }
    }
    float* rope = PTR(float, WS_ROPE);
    for (int i = F.gtid; i < SEQ * 16; i += GT) { const int s = i >> 4, j = i & 15;
        const float inv = exp2f(-(float)(2 * j) * (1.0f / 32.0f) * 13.287712379549449f);
        const float ang = (float)s * inv;
        const double rev = (double)ang * 0.15915494309189535; const double fr = rev - floor(rev);
        const double a = fr * 6.283185307179586;
        rope[2 * i] = (float)cos(a); rope[2 * i + 1] = (float)sin(a); }
    bf16* xb = PTR(bf16, F_XB); float* rinv = SMALLP(float, SM_RINV);
    for (int m = F.gw; m < NTOK; m += NGW) row_to_bf16_rinv(F, inp(F, 0) + (size_t)m * DM, xb + (size_t)m * DM, rinv + m);
}

__device__ __forceinline__ void phase_a1(const Frame& F, int l) {
    const bf16* xb = PTR(bf16, F_XB); const bf16* w = wl(F, l, WO_IN); const float* rinv = SMALLP(float, SM_RINV); const float* rope = PTR(float, WS_ROPE);
    bf16* CQ = PTR(bf16, F_CQ); bf16* CKVX = PTR(bf16, F_CKVX); bf16* KR = PTR(bf16, F_KR); bf16* U = PTR(bf16, F_U); bf16* SBQ = PTR(bf16, F_SBQ); bf16* SBK = PTR(bf16, F_SBK); bf16* SBVT = PTR(bf16, F_SBVT);
    float* SSQQ = SMALLP(float, SM_SSQQ); float* SSQKV = SMALLP(float, SM_SSQKV);
    for (size_t idx = F.gtid; idx < (size_t)NTOK * NPAD; idx += GT) {
        const int t = (int)(idx / NPAD), n = (int)(idx % NPAD), b = t >> 12, s = t & 4095;
        float val = 0.f;
        if (!(n >= 416 && n < 512)) val = dot_bf16(xb + (size_t)t * DM, w + (size_t)n * DM, DM) * rinv[t];
        const float other = __shfl_xor(val, 4);
        if (n < 256) { CQ[(size_t)t * 256 + n] = (bf16)f2bf(val); const float q = wave_sum(val * val); if (F.lane == 0) SSQQ[t * 4 + (n >> 6)] = q; }
        else if (n < 512) { CKVX[(size_t)t * 256 + (n - 256)] = (bf16)f2bf(val);
            if (n < 384) { const float q = wave_sum(val * val); if (F.lane == 0) { SSQKV[t * 4 + ((n - 256) >> 6)] = q; SSQKV[t * 4 + 2 + ((n - 256) >> 6)] = 0.f; } }
            else if (n < 416) { const int i = rope_feat(n - 384), j = i & 15; const float c = rope[(s * 16 + j) * 2], sn = rope[(s * 16 + j) * 2 + 1];
                const float o = i < 16 ? val * c - other * sn : val * c + other * sn; KR[idx_KR(b, s, i)] = (bf16)f2bf(o); } }
        else if (n < 768) { const int h = (n - 512) >> 6, d = (n - 512) & 63; SBQ[idx_SB(b, h, s, d)] = (bf16)f2bf(val * QSCALE_B); }
        else if (n < 1024) { const int h = (n - 768) >> 6, d = (n - 768) & 63; SBK[idx_SB(b, h, s, d)] = (bf16)f2bf(val); }
        else if (n < 1280) { U[(size_t)t * 256 + (n - 1024)] = (bf16)f2bf(val); }
        else { SBVT[(size_t)(n - 1280) * NTOK + perm16(t)] = (bf16)f2bf(val); }
    }
}

__device__ __forceinline__ void phase_a2(const Frame& F, int l) {
    const bf16* CQ = PTR(bf16, F_CQ); const bf16* CKVX = PTR(bf16, F_CKVX); const float* SSQQ = SMALLP(float, SM_SSQQ); const float* SSQKV = SMALLP(float, SM_SSQKV); const float* rope = PTR(float, WS_ROPE);
    bf16* Q = PTR(bf16, F_Q); bf16* KN = PTR(bf16, F_KN); bf16* VT = PTR(bf16, F_VT);
    const bf16* wq = wl(F, l, WO_UQ); const bf16* wkv = wl(F, l, WO_UKV);
    for (size_t idx = F.gtid; idx < (size_t)NTOK * 768; idx += GT) {
        const int t = (int)(idx / 768), n = (int)(idx % 768), b = t >> 12, s = t & 4095;
        const float rq = 1.0f / sqrtf((SSQQ[t * 4] + SSQQ[t * 4 + 1] + SSQQ[t * 4 + 2] + SSQQ[t * 4 + 3]) * (1.0f / AQL) + EPS);
        const float val = dot_bf16(CQ + (size_t)t * 256, wq + (size_t)n * 256, 256) * rq;
        const float other = __shfl_xor(val, 4);
        if (n < 512) { Q[idx_Q(b, n >> 6, s, n & 63)] = (bf16)f2bf(val * QSCALE_A); }
        else { const int h = (n - 512) >> 5, i = rope_feat((n - 512) & 31), j = i & 15; const float c = rope[(s * 16 + j) * 2], sn = rope[(s * 16 + j) * 2 + 1];
            const float o = i < 16 ? val * c - other * sn : val * c + other * sn; Q[idx_Q(b, h, s, 64 + i)] = (bf16)f2bf(o * QSCALE_A); }
    }
    for (size_t idx = F.gtid; idx < (size_t)NTOK * 1024; idx += GT) {
        const int t = (int)(idx >> 10), n = (int)(idx & 1023), b = t >> 12, s = t & 4095;
        const float rkv = 1.0f / sqrtf((SSQKV[t * 4] + SSQKV[t * 4 + 1] + SSQKV[t * 4 + 2] + SSQKV[t * 4 + 3]) * (1.0f / AKVL) + EPS);
        const float val = dot_bf16(CKVX + (size_t)t * 256, wkv + (size_t)n * 256, 256) * rkv;
        if (n < 512) KN[idx_KN(b, n >> 6, s, n & 63)] = (bf16)f2bf(val);
        else VT[(size_t)(n - 512) * NTOK + perm16(t)] = (bf16)f2bf(val);
    }
}

__device__ __forceinline__ void phase_a3(const Frame& F, int l) {
    const bf16* Q = PTR(bf16, F_Q); const bf16* KN = PTR(bf16, F_KN); const bf16* VT = PTR(bf16, F_VT); const bf16* KR = PTR(bf16, F_KR);
    const bf16* SBQ = PTR(bf16, F_SBQ); const bf16* SBK = PTR(bf16, F_SBK); const bf16* SBVT = PTR(bf16, F_SBVT); const bf16* U = PTR(bf16, F_U);
    bf16* MIX = PTR(bf16, F_MIX);
    for (int idx = F.gtid; idx < NBATCH * AH * SEQ; idx += GT) {
        const int s = idx & 4095, h = (idx >> 12) & 7, b = idx >> 15;
        unsigned qp[48];
#pragma unroll
        for (int i = 0; i < 12; ++i) { const v4u v = *(const v4u*)(Q + idx_Q(b, h, s, 8 * i)); qp[4 * i] = v.x; qp[4 * i + 1] = v.y; qp[4 * i + 2] = v.z; qp[4 * i + 3] = v.w; }
        float acc[64];
#pragma unroll
        for (int d = 0; d < 64; ++d) acc[d] = 0.f;
        float m = -INFINITY, lsum = 0.f;
        const int nkeys = ((s >> 6) + 1) * 64;
        for (int key = 0; key < nkeys; ++key) {
            float sc = 0.f;
#pragma unroll
            for (int c = 0; c < 8; ++c) { const v4u kv = *(const v4u*)(KN + idx_KN(b, h, key, 8 * c));
                sc += bflo(qp[4 * c]) * bflo(kv.x) + bfhi(qp[4 * c]) * bfhi(kv.x) + bflo(qp[4 * c + 1]) * bflo(kv.y) + bfhi(qp[4 * c + 1]) * bfhi(kv.y)
                    + bflo(qp[4 * c + 2]) * bflo(kv.z) + bfhi(qp[4 * c + 2]) * bfhi(kv.z) + bflo(qp[4 * c + 3]) * bflo(kv.w) + bfhi(qp[4 * c + 3]) * bfhi(kv.w); }
#pragma unroll
            for (int c = 0; c < 4; ++c) { const v4u kv = *(const v4u*)(KR + idx_KR(b, key, 8 * c)); const int o = 32 + 4 * c;
                sc += bflo(qp[o]) * bflo(kv.x) + bfhi(qp[o]) * bfhi(kv.x) + bflo(qp[o + 1]) * bflo(kv.y) + bfhi(qp[o + 1]) * bfhi(kv.y)
                    + bflo(qp[o + 2]) * bflo(kv.z) + bfhi(qp[o + 2]) * bfhi(kv.z) + bflo(qp[o + 3]) * bflo(kv.w) + bfhi(qp[o + 3]) * bfhi(kv.w); }
            const float mn = fmaxf(m, sc), f = exp2f(m - mn), p = exp2f(sc - mn);
            lsum = lsum * f + p; m = mn;
            const size_t vcol = (size_t)perm16(b * SEQ + key);
#pragma unroll
            for (int d = 0; d < 64; ++d) acc[d] = acc[d] * f + p * bf2f(VT[(size_t)(h * 64 + d) * NTOK + vcol]);
        }
        const float il = 1.0f / lsum;
#pragma unroll
        for (int d = 0; d < 64; d += 2) *(unsigned*)(MIX + (size_t)(b * SEQ + s) * DM + h * 64 + d) = pk2(acc[d] * il, acc[d + 1] * il);
    }
    for (int idx = F.gtid; idx < NBATCH * BHD * SEQ; idx += GT) {
        const int s = idx & 4095, h = (idx >> 12) & 3, b = idx >> 14;
        unsigned qp[32];
#pragma unroll
        for (int i = 0; i < 8; ++i) { const v4u v = *(const v4u*)(SBQ + idx_SB(b, h, s, 8 * i)); qp[4 * i] = v.x; qp[4 * i + 1] = v.y; qp[4 * i + 2] = v.z; qp[4 * i + 3] = v.w; }
        float acc[64];
#pragma unroll
        for (int d = 0; d < 64; ++d) acc[d] = 0.f;
        float carry = 0.f;
        for (int key = s - 1; key >= 0; --key) {
            float z = 0.f;
#pragma unroll
            for (int c = 0; c < 8; ++c) { const v4u kv = *(const v4u*)(SBK + idx_SB(b, h, key, 8 * c));
                z += bflo(qp[4 * c]) * bflo(kv.x) + bfhi(qp[4 * c]) * bfhi(kv.x) + bflo(qp[4 * c + 1]) * bflo(kv.y) + bfhi(qp[4 * c + 1]) * bfhi(kv.y)
                   + bflo(qp[4 * c + 2]) * bflo(kv.z) + bfhi(qp[4 * c + 2]) * bfhi(kv.z) + bflo(qp[4 * c + 3]) * bflo(kv.w) + bfhi(qp[4 * c + 3]) * bfhi(kv.w); }
            const float sp = fmaxf(z, 0.f) + log2f(1.0f + exp2f(-fabsf(z)));
            const float a = exp2f(z - sp + carry);
            carry -= sp;
            const size_t vcol = (size_t)perm16(b * SEQ + key);
#pragma unroll
            for (int d = 0; d < 64; ++d) acc[d] += a * bf2f(SBVT[(size_t)(h * 64 + d) * NTOK + vcol]);
        }
#pragma unroll
        for (int d = 0; d < 64; d += 2) *(unsigned*)(MIX + (size_t)(b * SEQ + s) * DM + 512 + h * 64 + d) = pk2(acc[d], acc[d + 1]);
    }
    const float* pw = inp(F, 7) + (size_t)l * 4 * 64 * 64; const float* ps = inp(F, 8) + l * 256;
    for (int idx = F.gtid; idx < NTOK * 256; idx += GT) {
        const int t = idx >> 8, cc = idx & 255, g = cc >> 6, co = cc & 63, s = t & 4095, w = 2 << g;
        const int cnt = (s + 1) < w ? (s + 1) : w; const float ic = 1.0f / (float)cnt;
        float acc = 0.f;
        for (int c = 0; c < 64; ++c) {
            float sum = 0.f;
            for (int j = 0; j < cnt; ++j) sum += bf2f(U[(size_t)(t - j) * 256 + g * 64 + c]);
            const float d = sum * ic - bf2f(U[(size_t)t * 256 + g * 64 + c]);
            acc += d * pw[(g * 64 + c) * 64 + co];
        }
        MIX[(size_t)t * DM + 768 + cc] = (bf16)f2bf(acc * ps[cc]);
    }
}

__device__ __forceinline__ void phase_a4(const Frame& F, int l) {
    const bf16* MIX = PTR(bf16, F_MIX); const bf16* w = wl(F, l, WO_OUT); bf16* xb = PTR(bf16, F_XB);
    const float* xin = l == 0 ? inp(F, 0) : F.X;
    for (size_t idx = F.gtid; idx < (size_t)NTOK * DM; idx += GT) {
        const int t = (int)(idx >> 10), n = (int)(idx & 1023);
        const float v = xin[idx] + dot_bf16(MIX + (size_t)t * DM, w + (size_t)n * DM, DM);
        F.X[idx] = v; xb[idx] = (bf16)f2bf(v);
    }
}

typedef short m1_bf16x8 __attribute__((ext_vector_type(8)));
__device__ __forceinline__ unsigned m1_cvtpk(float lo, float hi) { unsigned r; asm("v_cvt_pk_bf16_f32 %0, %1, %2" : "=v"(r) : "v"(lo), "v"(hi)); return r; }
__device__ __forceinline__ void phase_m1(const Frame& F, int l) {
    const bf16* wh = PTR(bf16, WS_WR) + (size_t)l * 2 * 48 * 1024; const bf16* wlo = wh + 48 * 1024;
    const float* bg = inp(F, 12) + l * 4; const float* be = inp(F, 14) + l * 32;
    float* R2 = SMALLP(float, SM_R2); int* RTE = SMALLP(int, SM_RTE); int* RTPOS = SMALLP(int, SM_RTPOS); float* RTC = SMALLP(float, SM_RTC);
    unsigned* cnt = F.ctl + CW_CNT + (size_t)l * 32 * 64;
    LAS unsigned* lcnt = (LAS unsigned*)(F.lds + 8 * 4096); LAS unsigned* lbase = lcnt + 32;
    if (F.tid < 32) lcnt[F.tid] = 0u;
    __syncthreads();
    const bool active = (F.gw & 1) == 0;
    const int task = F.gw >> 1, lane = F.lane, c16 = lane & 15, kq = lane >> 4, t0 = task * 16;
    int e1 = 0, e2 = 0; unsigned k1 = 0, k2 = 0; float cw1 = 0.f, cw2 = 0.f, r2 = 0.f;
    if (active) {
        const float* xrow = F.X + (size_t)(t0 + c16) * DM + 8 * kq;
        const bf16* whp = wh + (size_t)c16 * 1024 + 8 * kq; const bf16* wlp = wlo + (size_t)c16 * 1024 + 8 * kq;
        f32x4 acc[3]; float ssq = 0.f;
#pragma unroll
        for (int nb = 0; nb < 3; ++nb) acc[nb] = (f32x4){0.f, 0.f, 0.f, 0.f};
#pragma unroll 4
        for (int s = 0; s < 32; ++s) {
            const f32x4 x0 = *(const f32x4*)(xrow + 32 * s), x1 = *(const f32x4*)(xrow + 32 * s + 4);
            ssq += (x0[0] * x0[0] + x0[1] * x0[1]) + (x0[2] * x0[2] + x0[3] * x0[3]) + (x1[0] * x1[0] + x1[1] * x1[1]) + (x1[2] * x1[2] + x1[3] * x1[3]);
            v4u hw, lw;
            hw.x = m1_cvtpk(x0[0], x0[1]); hw.y = m1_cvtpk(x0[2], x0[3]); hw.z = m1_cvtpk(x1[0], x1[1]); hw.w = m1_cvtpk(x1[2], x1[3]);
            lw.x = m1_cvtpk(x0[0] - bflo(hw.x), x0[1] - bfhi(hw.x)); lw.y = m1_cvtpk(x0[2] - bflo(hw.y), x0[3] - bfhi(hw.y));
            lw.z = m1_cvtpk(x1[0] - bflo(hw.z), x1[1] - bfhi(hw.z)); lw.w = m1_cvtpk(x1[2] - bflo(hw.w), x1[3] - bfhi(hw.w));
            const m1_bf16x8 xh = __builtin_bit_cast(m1_bf16x8, hw), xl = __builtin_bit_cast(m1_bf16x8, lw);
#pragma unroll
            for (int nb = 0; nb < 3; ++nb) { const m1_bf16x8 bh = *(const m1_bf16x8*)(whp + (size_t)nb * 16 * 1024 + 32 * s), bl = *(const m1_bf16x8*)(wlp + (size_t)nb * 16 * 1024 + 32 * s);
                acc[nb] = __builtin_amdgcn_mfma_f32_16x16x32_bf16(bh, xh, acc[nb], 0, 0, 0); acc[nb] = __builtin_amdgcn_mfma_f32_16x16x32_bf16(bl, xh, acc[nb], 0, 0, 0); acc[nb] = __builtin_amdgcn_mfma_f32_16x16x32_bf16(bh, xl, acc[nb], 0, 0, 0); }
        }
        ssq += __shfl_xor(ssq, 16); ssq += __shfl_xor(ssq, 32);
        r2 = 1.0f / sqrtf(ssq * (1.0f / DM) + EPS);
        LAS float* lg = (LAS float*)(F.lds + F.wave * 4096);
#pragma unroll
        for (int nb = 0; nb < 3; ++nb)
#pragma unroll
            for (int e = 0; e < 4; ++e) lg[c16 * 49 + 16 * nb + 4 * kq + e] = acc[nb][e] * r2;
        LDS_WAIT(); asm volatile("" ::: "memory");
        if (lane < 16) {
            const LAS float* my = lg + lane * 49;
            const float l0 = my[0] + bg[0], l1 = my[1] + bg[1], l2 = my[2] + bg[2], l3 = my[3] + bg[3];
            int g = 0; float gm = l0;
            if (l1 > gm) { gm = l1; g = 1; }
            if (l2 > gm) { gm = l2; g = 2; }
            if (l3 > gm) { gm = l3; g = 3; }
            const float psel = 1.0f / (expf(l0 - gm) + expf(l1 - gm) + expf(l2 - gm) + expf(l3 - gm));
            int i1 = 0, i2 = 0; float m1 = -INFINITY, m2 = -INFINITY;
#pragma unroll
            for (int e = 0; e < 8; ++e) { const float v = my[4 + 8 * g + e] + be[8 * g + e];
                if (v > m1) { m2 = m1; i2 = i1; m1 = v; i1 = e; } else if (v > m2) { m2 = v; i2 = e; } }
            const float ex = expf(m2 - m1), w1 = 1.0f / (1.0f + ex), w2 = ex / (1.0f + ex);
            e1 = g * 8 + i1; e2 = g * 8 + i2; cw1 = psel * w1; cw2 = psel * w2;
            k1 = __hip_atomic_fetch_add(lcnt + e1, 1u, __ATOMIC_RELAXED, __HIP_MEMORY_SCOPE_WORKGROUP); k2 = __hip_atomic_fetch_add(lcnt + e2, 1u, __ATOMIC_RELAXED, __HIP_MEMORY_SCOPE_WORKGROUP);
        }
    }
    __syncthreads();
    if (F.tid < 32) { const unsigned c = lcnt[F.tid]; lbase[F.tid] = c ? atomicAdd(cnt + F.tid * 64, c) : 0u; }
    __syncthreads();
    if (active && lane < 16) { const int t = t0 + lane;
        R2[t] = r2; RTE[2 * t] = e1; RTE[2 * t + 1] = e2; RTPOS[2 * t] = (int)(lbase[e1] + k1); RTPOS[2 * t + 1] = (int)(lbase[e2] + k2); RTC[2 * t] = cw1; RTC[2 * t + 1] = cw2; }
}
constexpr int LDS_TAB = CTRL_BASE + 512;
__device__ __forceinline__ void moe_offsets(const Frame& F, int l) {
    LAS int* off = (LAS int*)(F.lds + LDS_TAB); LAS int* cn = (LAS int*)(F.lds + LDS_TAB + 256); LAS int* te = (LAS int*)(F.lds + LDS_TAB + 512);
    __syncthreads();
    if (F.tid < 32) cn[F.tid] = (int)__hip_atomic_load(F.ctl + CW_CNT + (l * 32 + F.tid) * 64, RLX_AGENT);
    __syncthreads();
    if (F.tid == 0) { int a = 0; for (int e = 0; e < 32; ++e) { const int c = cn[e]; off[e] = a;
            const int np = (c + 255) & ~255; for (int tt = a >> 8; tt < ((a + np) >> 8); ++tt) te[tt] = e; a += np; } off[32] = a; }
    __syncthreads();
}
__device__ __forceinline__ int find_expert(LAS int* off, int r) { int e = 0; for (int j = 1; j < 32; ++j) if (r >= off[j]) e = j; return e; }

__device__ __forceinline__ void phase_m2(const Frame& F, int l) {
    moe_offsets(F, l);
    LAS int* off = (LAS int*)(F.lds + LDS_TAB); LAS int* cn = (LAS int*)(F.lds + LDS_TAB + 256);
    const float* R2 = SMALLP(float, SM_R2); const int* RTE = SMALLP(int, SM_RTE); const int* RTPOS = SMALLP(int, SM_RTPOS); const float* RTC = SMALLP(float, SM_RTC);
    int* TROW = SMALLP(int, SM_TROW); float* ROWR2 = SMALLP(float, SM_ROWR2); float* ROWC = SMALLP(float, SM_ROWC); int* ROWTOK = SMALLP(int, SM_ROWTOK);
    for (int idx = F.gtid; idx < NTOK * 2; idx += GT) { const int t = idx >> 1, e = RTE[idx], row = off[e] + RTPOS[idx];
        ROWTOK[row] = t; ROWC[row] = RTC[idx]; ROWR2[row] = R2[t]; TROW[idx] = row; }
    const int rtot = off[32];
    for (int r = F.gtid; r < rtot; r += GT) { const int e = find_expert(off, r); if (r - off[e] >= cn[e]) { ROWTOK[r] = 0; ROWC[r] = 0.f; ROWR2[r] = 0.f; } }
}
__device__ __forceinline__ void phase_m3(const Frame& F, int l) {
    moe_offsets(F, l);
    LAS int* off = (LAS int*)(F.lds + LDS_TAB); LAS int* cn = (LAS int*)(F.lds + LDS_TAB + 256);
    const bf16* xb = PTR(bf16, F_XB); const bf16* w = wl(F, l, WO_GU); bf16* H = PTR(bf16, F_H);
    const float* ROWR2 = SMALLP(float, SM_ROWR2); const float* ROWC = SMALLP(float, SM_ROWC); const int* ROWTOK = SMALLP(int, SM_ROWTOK);
    const int rtot = off[32];
    for (size_t idx = F.gtid; idx < (size_t)rtot * 256; idx += GT) {
        const int r = (int)(idx >> 8), f = (int)(idx & 255), e = find_expert(off, r);
        if (r - off[e] >= cn[e]) continue;
        const bf16* xr = xb + (size_t)ROWTOK[r] * DM; const bf16* wg = w + ((size_t)e * 512 + 256 * (f >> 7) + (f & 127)) * DM;
        const float r2 = ROWR2[r]; const float a = dot_bf16(xr, wg, DM) * r2, bb = dot_bf16(xr, wg + (size_t)128 * DM, DM) * r2;
        H[(size_t)r * 256 + f] = (bf16)f2bf(a / (1.0f + expf(-a)) * bb * ROWC[r]);
    }
}
__device__ __forceinline__ void phase_m4(const Frame& F, int l) {
    moe_offsets(F, l);
    LAS int* off = (LAS int*)(F.lds + LDS_TAB); LAS int* cn = (LAS int*)(F.lds + LDS_TAB + 256);
    const bf16* H = PTR(bf16, F_H); const bf16* w = wl(F, l, WO_D); bf16* Y = PTR(bf16, F_Y);
    const int rtot = off[32];
    for (size_t idx = F.gtid; idx < (size_t)rtot * 1024; idx += GT) {
        const int r = (int)(idx >> 10), n = (int)(idx & 1023), e = find_expert(off, r);
        if (r - off[e] >= cn[e]) continue;
        Y[idx] = (bf16)f2bf(dot_bf16(H + (size_t)r * 256, w + ((size_t)e * 1024 + n) * 256, 256));
    }
}
__device__ __forceinline__ void phase_m5(const Frame& F, int l) {
    const bf16* Y = PTR(bf16, F_Y); const int* RTE = SMALLP(int, SM_RTE); const int* RTPOS = SMALLP(int, SM_RTPOS); bf16* xb = PTR(bf16, F_XB); float* rinv = SMALLP(float, SM_RINV);
    moe_offsets(F, l);
    const LAS int* off = (const LAS int*)(F.lds + LDS_TAB);
    const float* fg = inp(F, 18);
    typedef unsigned v2u __attribute__((ext_vector_type(2)));
#pragma unroll 1
    for (int t = F.gw; t < NTOK; t += NGW) {
        const int r0 = off[RTE[2 * t]] + RTPOS[2 * t], r1 = off[RTE[2 * t + 1]] + RTPOS[2 * t + 1];
        float* xr = F.X + (size_t)t * DM + 4 * F.lane; const bf16* y0 = Y + (size_t)r0 * DM + 4 * F.lane; const bf16* y1 = Y + (size_t)r1 * DM + 4 * F.lane;
        f32x4 xv[4]; v2u a[4], c[4];
#pragma unroll
        for (int j = 0; j < 4; ++j) { xv[j] = *(const f32x4*)(xr + 256 * j); a[j] = *(const v2u*)(y0 + 256 * j); c[j] = *(const v2u*)(y1 + 256 * j); }
        float ss = 0.f;
#pragma unroll
        for (int j = 0; j < 4; ++j) { xv[j][0] += bflo(a[j].x) + bflo(c[j].x); xv[j][1] += bfhi(a[j].x) + bfhi(c[j].x); xv[j][2] += bflo(a[j].y) + bflo(c[j].y); xv[j][3] += bfhi(a[j].y) + bfhi(c[j].y);
            ss += (xv[j][0] * xv[j][0] + xv[j][1] * xv[j][1]) + (xv[j][2] * xv[j][2] + xv[j][3] * xv[j][3]); }
        ss = wave_sum(ss);
        const float r = 1.0f / sqrtf(ss * (1.0f / DM) + EPS);
        if (l == DEPTH - 1) {
#pragma unroll
            for (int j = 0; j < 4; ++j) { const f32x4 gv = *(const f32x4*)(fg + 4 * F.lane + 256 * j); *(f32x4*)(xr + 256 * j) = xv[j] * r * gv; }
        } else {
#pragma unroll
            for (int j = 0; j < 4; ++j) { *(f32x4*)(xr + 256 * j) = xv[j]; v2u o; o.x = pk2(xv[j][0], xv[j][1]); o.y = pk2(xv[j][2], xv[j][3]); *(v2u*)(xb + (size_t)t * DM + 4 * F.lane + 256 * j) = o; }
            if (F.lane == 0) rinv[t] = r;
        }
    }
}

#ifndef FAST_A3
#define FAST_A3 1
#endif
namespace attn {
typedef short bf16x8 __attribute__((ext_vector_type(8)));
typedef float f32x16 __attribute__((ext_vector_type(16)));
typedef unsigned u32x4 __attribute__((ext_vector_type(4)));
constexpr int KSLOT = 12288, VSLOT = 8192, SLOT = KSLOT + VSLOT;
constexpr int LDS_WSF = 2 * SLOT, LDS_OST = LDS_WSF + NWAVES * 256, LDS_END = LDS_OST + NWAVES * 4096;
static_assert(LDS_END <= 131072, "attention LDS");
__device__ __forceinline__ int crow(int r, int hi) { return (r & 3) + 8 * (r >> 2) + 4 * hi; }
__device__ __forceinline__ unsigned cvtpk(float lo, float hi) { unsigned r; asm("v_cvt_pk_bf16_f32 %0, %1, %2" : "=v"(r) : "v"(lo), "v"(hi)); return r; }
__device__ __forceinline__ bf16x8 pack_frag(const f32x16& p, int base) {
    u32x4 w; w.x = cvtpk(p[base], p[base + 1]); w.y = cvtpk(p[base + 2], p[base + 3]); w.z = cvtpk(p[base + 4], p[base + 5]); w.w = cvtpk(p[base + 6], p[base + 7]);
    return __builtin_bit_cast(bf16x8, w);
}
__device__ __forceinline__ float half_max(float v) { auto rr = __builtin_amdgcn_permlane32_swap(__float_as_uint(v), __float_as_uint(v), false, false); return fmaxf(__uint_as_float(rr[0]), __uint_as_float(rr[1])); }
__device__ __forceinline__ float half_sum(float v) { auto rr = __builtin_amdgcn_permlane32_swap(__float_as_uint(v), __float_as_uint(v), false, false); return __uint_as_float(rr[0]) + __uint_as_float(rr[1]); }
__device__ __forceinline__ void store_o(LAS unsigned char* lds, int w, int lane, const f32x16& o0, const f32x16& o1, bf16* dst) {
    const int r32 = lane & 31, hi = lane >> 5;
    LAS bf16* stg = (LAS bf16*)(lds + LDS_OST + w * 4096);
#pragma unroll
    for (int r = 0; r < 16; ++r) { const int q = crow(r, hi); stg[q * 64 + r32] = (bf16)(cvtpk(o0[r], 0.f) & 0xffffu); stg[q * 64 + 32 + r32] = (bf16)(cvtpk(o1[r], 0.f) & 0xffffu); }
#pragma unroll
    for (int i = 0; i < 4; ++i) { const int row = i * 8 + (lane >> 3), ch = lane & 7; const u32x4 v = *(const LAS u32x4*)(stg + row * 64 + ch * 8); *(u32x4*)(dst + (size_t)row * DM + ch * 8) = v; }
}
__device__ __forceinline__ void mla_unit(const Frame& F, int b, int h, int qb) {
    const int lane = F.lane, w = F.wave, r32 = lane & 31, hi = lane >> 5;
    LAS unsigned char* lds = F.lds;
    const bf16* Q = PTR(bf16, F_Q); const bf16* KN = PTR(bf16, F_KN); const bf16* KR = PTR(bf16, F_KR); const bf16* VT = PTR(bf16, F_VT); bf16* MIX = PTR(bf16, F_MIX);
    const int s0 = qb * 256 + w * 32, cq = s0 >> 6, NT = 4 * qb + 4;
    bf16x8 qr[6];
    { const bf16* qrow = Q + idx_Q(b, h, s0 + r32, 0);
#pragma unroll
      for (int d0 = 0; d0 < 6; ++d0) qr[d0] = *(const bf16x8*)(qrow + 16 * d0 + 8 * hi); }
    f32x16 o0, o1;
#pragma unroll
    for (int r = 0; r < 16; ++r) { o0[r] = 0.f; o1[r] = 0.f; }
    float mref = -INFINITY, lsum = 0.f;
    LAS float* wsf = (LAS float*)(lds + LDS_WSF) + w * 64;
    const bf16* kn_src = KN + ((((size_t)b * 8 + h) * 64) * 8 + w) * 512 + lane * 8;
    const bf16* kr_src = KR + ((((size_t)b * 64) * 4) + (w & 3)) * 512 + lane * 8;
    const int vd = 8 * w + (lane >> 3), vch = (lane & 7) ^ ((vd >> 1) & 7);
    const bf16* v_src = VT + (size_t)(h * 64 + vd) * NTOK + b * SEQ + vch * 8;
#define MLA_DMA(kt, buf) do { LAS unsigned char* base_ = lds + (buf) * SLOT; \
        __builtin_amdgcn_global_load_lds((const unsigned*)(kn_src + (size_t)(kt) * 4096), (LAS unsigned*)(base_ + w * 1024), 16, 0, 0); \
        if (w < 4) __builtin_amdgcn_global_load_lds((const unsigned*)(kr_src + (size_t)(kt) * 2048), (LAS unsigned*)(base_ + (8 + w) * 1024), 16, 0, 0); \
        __builtin_amdgcn_global_load_lds((const unsigned*)(v_src + (size_t)(kt) * 64), (LAS unsigned*)(base_ + KSLOT + w * 1024), 16, 0, 0); } while (0)
    MLA_DMA(0, 0);
#pragma unroll 1
    for (int kt = 0; kt < NT; ++kt) {
        const int buf = kt & 1;
        asm volatile("s_waitcnt vmcnt(0)" ::: "memory");
        __builtin_amdgcn_s_barrier(); asm volatile("" ::: "memory");
        if (kt + 1 < NT) MLA_DMA(kt + 1, buf ^ 1);
        if (kt <= cq) {
            const LAS unsigned char* kb = lds + buf * SLOT + hi * 1024 + r32 * 16;
            f32x16 p0, p1;
#pragma unroll
            for (int r = 0; r < 16; ++r) { p0[r] = 0.f; p1[r] = 0.f; }
#pragma unroll
            for (int d0 = 0; d0 < 6; ++d0) { const bf16x8 a0 = *(const LAS bf16x8*)(kb + d0 * 2048), a1 = *(const LAS bf16x8*)(kb + d0 * 2048 + 512);
                p0 = __builtin_amdgcn_mfma_f32_32x32x16_bf16(a0, qr[d0], p0, 0, 0, 0); p1 = __builtin_amdgcn_mfma_f32_32x32x16_bf16(a1, qr[d0], p1, 0, 0, 0); }
            float mt = fmaxf(p0[0], p1[0]);
#pragma unroll
            for (int r = 1; r < 16; ++r) mt = fmaxf(mt, fmaxf(p0[r], p1[r]));
            mt = half_max(mt);
            if (__any(mt > mref + 6.0f)) {
                const float mn = fmaxf(mref, mt), alpha = __builtin_amdgcn_exp2f(mref - mn);
                lsum *= alpha; mref = mn;
                if (hi == 0) wsf[r32] = alpha;
#pragma unroll
                for (int r = 0; r < 16; ++r) { const float f = wsf[crow(r, hi)]; o0[r] *= f; o1[r] *= f; }
            }
            float ls0 = 0.f, ls1 = 0.f;
#pragma unroll
            for (int r = 0; r < 16; ++r) { p0[r] = __builtin_amdgcn_exp2f(p0[r] - mref); p1[r] = __builtin_amdgcn_exp2f(p1[r] - mref); ls0 += p0[r]; ls1 += p1[r]; }
            lsum += ls0 + ls1;
            const bf16x8 pa0 = pack_frag(p0, 0), pa1 = pack_frag(p0, 8), pa2 = pack_frag(p1, 0), pa3 = pack_frag(p1, 8);
            const LAS unsigned char* vb = lds + buf * SLOT + KSLOT;
#pragma unroll
            for (int dv = 0; dv < 2; ++dv) { const int d = 32 * dv + r32, sw = (d >> 1) & 7; const LAS unsigned char* vr = vb + d * 128;
                const bf16x8 v0 = *(const LAS bf16x8*)(vr + (((0 + hi) ^ sw) << 4)), v1 = *(const LAS bf16x8*)(vr + (((2 + hi) ^ sw) << 4)),
                             v2 = *(const LAS bf16x8*)(vr + (((4 + hi) ^ sw) << 4)), v3 = *(const LAS bf16x8*)(vr + (((6 + hi) ^ sw) << 4));
                if (dv == 0) { o0 = __builtin_amdgcn_mfma_f32_32x32x16_bf16(pa0, v0, o0, 0, 0, 0); o0 = __builtin_amdgcn_mfma_f32_32x32x16_bf16(pa1, v1, o0, 0, 0, 0);
                               o0 = __builtin_amdgcn_mfma_f32_32x32x16_bf16(pa2, v2, o0, 0, 0, 0); o0 = __builtin_amdgcn_mfma_f32_32x32x16_bf16(pa3, v3, o0, 0, 0, 0); }
                else         { o1 = __builtin_amdgcn_mfma_f32_32x32x16_bf16(pa0, v0, o1, 0, 0, 0); o1 = __builtin_amdgcn_mfma_f32_32x32x16_bf16(pa1, v1, o1, 0, 0, 0);
                               o1 = __builtin_amdgcn_mfma_f32_32x32x16_bf16(pa2, v2, o1, 0, 0, 0); o1 = __builtin_amdgcn_mfma_f32_32x32x16_bf16(pa3, v3, o1, 0, 0, 0); }
            }
        }
    }
#undef MLA_DMA
    const float inv = 1.0f / half_sum(lsum);
    if (hi == 0) wsf[32 + r32] = inv;
#pragma unroll
    for (int r = 0; r < 16; ++r) { const float f = wsf[32 + crow(r, hi)]; o0[r] *= f; o1[r] *= f; }
    store_o(lds, w, lane, o0, o1, MIX + (size_t)(b * SEQ + s0) * DM + h * 64);
}
__device__ __forceinline__ void sb_task(const Frame& F, int task) {
    const int lane = F.lane, w = F.wave, r32 = lane & 31, hi = lane >> 5;
    const int bh = task >> 7, blk = task & 127, b = bh >> 2, h = bh & 3, q0 = blk * 32, q = q0 + r32;
    const bf16* SBQ = PTR(bf16, F_SBQ); const bf16* SBK = PTR(bf16, F_SBK); const bf16* SBVT = PTR(bf16, F_SBVT); bf16* MIX = PTR(bf16, F_MIX);
    bf16x8 qr[4];
    { const bf16* qrow = SBQ + idx_SB(b, h, q, 0);
#pragma unroll
      for (int d0 = 0; d0 < 4; ++d0) qr[d0] = *(const bf16x8*)(qrow + 16 * d0 + 8 * hi); }
    f32x16 o0, o1;
#pragma unroll
    for (int r = 0; r < 16; ++r) { o0[r] = 0.f; o1[r] = 0.f; }
    float carry = 0.f;
    const bf16* kbase = SBK + idx_SB(b, h, 0, 0) + (size_t)r32 * 64 + 8 * hi;
    const bf16* vbase = SBVT + (size_t)(h * 64 + r32) * NTOK + b * SEQ + 8 * hi;
    const int ktd = q0 >> 6;
#pragma unroll 1
    for (int kt = ktd; kt >= 0; --kt) {
        f32x16 p0, p1;
#pragma unroll
        for (int r = 0; r < 16; ++r) { p0[r] = 0.f; p1[r] = 0.f; }
        const bf16* kp = kbase + (size_t)kt * 64 * 64;
#pragma unroll
        for (int d0 = 0; d0 < 4; ++d0) { const bf16x8 a0 = *(const bf16x8*)(kp + 16 * d0), a1 = *(const bf16x8*)(kp + 32 * 64 + 16 * d0);
            p0 = __builtin_amdgcn_mfma_f32_32x32x16_bf16(a0, qr[d0], p0, 0, 0, 0); p1 = __builtin_amdgcn_mfma_f32_32x32x16_bf16(a1, qr[d0], p1, 0, 0, 0); }
        f32x16 s0, s1; const bool diag = (kt == ktd); const int kb0 = kt * 64 + 4 * hi;
#pragma unroll
        for (int r = 0; r < 16; ++r) { const int key = kb0 + (r & 3) + 8 * (r >> 2);
            const float z0 = p0[r], z1 = p1[r];
            float a = fmaxf(z0, 0.f) + __builtin_amdgcn_logf(1.0f + __builtin_amdgcn_exp2f(-fabsf(z0)));
            float c = fmaxf(z1, 0.f) + __builtin_amdgcn_logf(1.0f + __builtin_amdgcn_exp2f(-fabsf(z1)));
            if (diag) { if (key >= q) { a = 0.f; p0[r] = -INFINITY; } if (key + 32 >= q) { c = 0.f; p1[r] = -INFINITY; } }
            s0[r] = a; s1[r] = c; }
        float gs[8];
#pragma unroll
        for (int g = 0; g < 4; ++g) { gs[g] = (s0[4 * g] + s0[4 * g + 1]) + (s0[4 * g + 2] + s0[4 * g + 3]); gs[4 + g] = (s1[4 * g] + s1[4 * g + 1]) + (s1[4 * g + 2] + s1[4 * g + 3]); }
        float GS[16];
#pragma unroll
        for (int k = 0; k < 8; ++k) { auto rr = __builtin_amdgcn_permlane32_swap(__float_as_uint(gs[k]), __float_as_uint(gs[k]), false, false); GS[2 * k] = __uint_as_float(rr[0]); GS[2 * k + 1] = __uint_as_float(rr[1]); }
        float T[16]; T[15] = 0.f;
#pragma unroll
        for (int G = 14; G >= 0; --G) T[G] = T[G + 1] + GS[G + 1];
#pragma unroll
        for (int k = 0; k < 8; ++k) {
            float run = carry - (hi ? T[2 * k + 1] : T[2 * k]);
#pragma unroll
            for (int e = 3; e >= 0; --e) { const int r = 4 * (k & 3) + e;
                if (k < 4) { const float sp = s0[r]; p0[r] = __builtin_amdgcn_exp2f(p0[r] - sp + run); run -= sp; }
                else       { const float sp = s1[r]; p1[r] = __builtin_amdgcn_exp2f(p1[r] - sp + run); run -= sp; } }
        }
        carry -= T[0] + GS[0];
        const bf16x8 pa0 = pack_frag(p0, 0), pa1 = pack_frag(p0, 8), pa2 = pack_frag(p1, 0), pa3 = pack_frag(p1, 8);
        const bf16* vp = vbase + kt * 64;
#pragma unroll
        for (int dv = 0; dv < 2; ++dv) { const bf16* vr = vp + (size_t)(32 * dv) * NTOK;
            const bf16x8 v0 = *(const bf16x8*)(vr), v1 = *(const bf16x8*)(vr + 16), v2 = *(const bf16x8*)(vr + 32), v3 = *(const bf16x8*)(vr + 48);
            if (dv == 0) { o0 = __builtin_amdgcn_mfma_f32_32x32x16_bf16(pa0, v0, o0, 0, 0, 0); o0 = __builtin_amdgcn_mfma_f32_32x32x16_bf16(pa1, v1, o0, 0, 0, 0);
                           o0 = __builtin_amdgcn_mfma_f32_32x32x16_bf16(pa2, v2, o0, 0, 0, 0); o0 = __builtin_amdgcn_mfma_f32_32x32x16_bf16(pa3, v3, o0, 0, 0, 0); }
            else         { o1 = __builtin_amdgcn_mfma_f32_32x32x16_bf16(pa0, v0, o1, 0, 0, 0); o1 = __builtin_amdgcn_mfma_f32_32x32x16_bf16(pa1, v1, o1, 0, 0, 0);
                           o1 = __builtin_amdgcn_mfma_f32_32x32x16_bf16(pa2, v2, o1, 0, 0, 0); o1 = __builtin_amdgcn_mfma_f32_32x32x16_bf16(pa3, v3, o1, 0, 0, 0); }
        }
        if (__all(carry < -160.0f)) break;
    }
    store_o(F.lds, w, lane, o0, o1, MIX + (size_t)(b * SEQ + q0) * DM + 512 + h * 64);
}
__device__ __forceinline__ void pool_task(const Frame& F, int task, int l) {
    const int lane = F.lane, r32 = lane & 31, hi = lane >> 5;
    const bf16* U = PTR(bf16, F_U); bf16* MIX = PTR(bf16, F_MIX);
    const float* pw = inp(F, 7) + (size_t)l * 4 * 64 * 64; const float* ps = inp(F, 8) + l * 256;
    const int t0 = task * 32, tok = t0 + r32, spos = tok & 4095;
#pragma unroll
    for (int g = 0; g < 4; ++g) {
        const int win = 2 << g; const int cnt = (spos + 1) < win ? (spos + 1) : win; const float ic = 1.0f / (float)cnt;
        f32x16 a0, a1;
#pragma unroll
        for (int r = 0; r < 16; ++r) { a0[r] = 0.f; a1[r] = 0.f; }
#pragma unroll
        for (int s = 0; s < 4; ++s) {
            const int cb = g * 64 + 16 * s + 8 * hi;
            const v4u own = *(const v4u*)(U + (size_t)tok * 256 + cb);
            float sum[8] = {bflo(own.x), bfhi(own.x), bflo(own.y), bfhi(own.y), bflo(own.z), bfhi(own.z), bflo(own.w), bfhi(own.w)};
            float me[8];
#pragma unroll
            for (int j = 0; j < 8; ++j) me[j] = sum[j];
#pragma unroll
            for (int jj = 1; jj < win; ++jj) if (jj < cnt) { const v4u x = *(const v4u*)(U + (size_t)(tok - jj) * 256 + cb);
                sum[0] += bflo(x.x); sum[1] += bfhi(x.x); sum[2] += bflo(x.y); sum[3] += bfhi(x.y); sum[4] += bflo(x.z); sum[5] += bfhi(x.z); sum[6] += bflo(x.w); sum[7] += bfhi(x.w); }
            u32x4 aw; aw.x = cvtpk(sum[0] * ic - me[0], sum[1] * ic - me[1]); aw.y = cvtpk(sum[2] * ic - me[2], sum[3] * ic - me[3]);
            aw.z = cvtpk(sum[4] * ic - me[4], sum[5] * ic - me[5]); aw.w = cvtpk(sum[6] * ic - me[6], sum[7] * ic - me[7]);
            const bf16x8 af = __builtin_bit_cast(bf16x8, aw);
#pragma unroll
            for (int dv = 0; dv < 2; ++dv) { const float* wp = pw + (size_t)(g * 64 + 16 * s + 8 * hi) * 64 + 32 * dv + r32;
                u32x4 bw; bw.x = cvtpk(wp[0], wp[64]); bw.y = cvtpk(wp[128], wp[192]); bw.z = cvtpk(wp[256], wp[320]); bw.w = cvtpk(wp[384], wp[448]);
                const bf16x8 bfg = __builtin_bit_cast(bf16x8, bw);
                if (dv == 0) a0 = __builtin_amdgcn_mfma_f32_32x32x16_bf16(af, bfg, a0, 0, 0, 0); else a1 = __builtin_amdgcn_mfma_f32_32x32x16_bf16(af, bfg, a1, 0, 0, 0); }
        }
        const float sc0 = ps[g * 64 + r32], sc1 = ps[g * 64 + 32 + r32];
#pragma unroll
        for (int r = 0; r < 16; ++r) { bf16* o = MIX + (size_t)(t0 + crow(r, hi)) * DM + 768 + g * 64 + r32;
            o[0] = (bf16)(cvtpk(a0[r] * sc0, 0.f) & 0xffffu); o[32] = (bf16)(cvtpk(a1[r] * sc1, 0.f) & 0xffffu); }
    }
}
}
__device__ __forceinline__ void phase_a3_fast(const Frame& F, int l) {
    const int v = (F.bid & 7) * 32 + (F.bid >> 3), pair = v >> 3, j = v & 7;
    attn::mla_unit(F, pair >> 3, pair & 7, j);
    attn::mla_unit(F, pair >> 3, pair & 7, 15 - j);
    attn::sb_task(F, F.gw);
    if ((F.gw & 3) == 0) attn::pool_task(F, F.gw >> 2, l);
}

#ifndef FAST_A1
#define FAST_A1 1
#endif
#ifndef FAST_A2
#define FAST_A2 1
#endif
#ifndef FAST_A4
#define FAST_A4 1
#endif
#ifndef FAST_M3
#define FAST_M3 1
#endif
#ifndef FAST_M4
#define FAST_M4 1
#endif
__device__ __forceinline__ void phase_a1_fast(const Frame& F, int l) {
    using namespace pg8; const int bid = F.bid;
    { Gemm g{PTR(bf16, F_XB), wl(F, l, WO_IN), NTOK, 1280, 1024}; StaticOrder S; S.init(NTOK, 1280, 256, bid);
      EpiA1 E{SMALLP(float, SM_RINV), PTR(float, WS_ROPE), PTR(bf16, F_CQ), PTR(bf16, F_CKVX), PTR(bf16, F_KR), PTR(bf16, F_U), PTR(bf16, F_SBQ), PTR(bf16, F_SBK), SMALLP(float, SM_SSQQ), SMALLP(float, SM_SSQKV)};
      gemm_phase<EpiA1, StaticOrder, true, false>(F.lds, g, S, E, nullptr); }
    { Gemm g{wl(F, l, WO_IN) + (size_t)1280 * 1024, PTR(bf16, F_XB), 256, NTOK, 1024}; StaticOrder S; S.init(256, NTOK, 256, (bid + 192) & 255);
      EpiVT E{PTR(bf16, F_SBVT), SMALLP(float, SM_RINV), 0};
      gemm_phase<EpiVT, StaticOrder, true, false>(F.lds, g, S, E, nullptr); }
}
__device__ __forceinline__ void phase_a2_fast(const Frame& F, int l) {
    using namespace pg8; const int bid = F.bid;
    { Gemm g{PTR(bf16, F_CQ), wl(F, l, WO_UQ), NTOK, 768, 256}; StaticOrder S; S.init(NTOK, 768, 256, bid);
      EpiQ E{SMALLP(float, SM_SSQQ), PTR(float, WS_ROPE), PTR(bf16, F_Q)};
      gemm_phase<EpiQ, StaticOrder, true, false>(F.lds, g, S, E, nullptr); }
    { Gemm g{PTR(bf16, F_CKVX), wl(F, l, WO_UKV), NTOK, 512, 256}; StaticOrder S; S.init(NTOK, 512, 256, (bid + 64) & 255);
      EpiKN E{SMALLP(float, SM_SSQKV), PTR(bf16, F_KN)};
      gemm_phase<EpiKN, StaticOrder, true, false>(F.lds, g, S, E, nullptr); }
    { Gemm g{wl(F, l, WO_UKV) + (size_t)512 * 256, PTR(bf16, F_CKVX), 512, NTOK, 256}; StaticOrder S; S.init(512, NTOK, 256, (bid + 192) & 255);
      EpiVT E{PTR(bf16, F_VT), SMALLP(float, SM_SSQKV), 1};
      gemm_phase<EpiVT, StaticOrder, true, false>(F.lds, g, S, E, nullptr); }
}
__device__ __forceinline__ void phase_a4_fast(const Frame& F, int l) {
    using namespace pg8;
    Gemm g{PTR(bf16, F_MIX), wl(F, l, WO_OUT), NTOK, DM, DM}; StaticOrder S; S.init(NTOK, DM, 256, F.bid);
    EpiOut E{l == 0 ? inp(F, 0) : F.X, F.X, PTR(bf16, F_XB)};
    gemm_phase<EpiOut, StaticOrder, true, false>(F.lds, g, S, E, nullptr);
}
__device__ __forceinline__ void phase_m3_fast(const Frame& F, int l) {
    using namespace pg8;
    moe_offsets(F, l);
    const LAS int* off = (const LAS int*)(F.lds + LDS_TAB);
    MoeOrder S{off[32] >> 8, 2, 256, F.bid, (const LAS int*)(F.lds + LDS_TAB + 512)};
    Gemm g{PTR(bf16, F_XB), wl(F, l, WO_GU), 0, 0, DM};
    EpiGU E{SMALLP(float, SM_ROWR2), SMALLP(float, SM_ROWC), PTR(bf16, F_H)};
    gemm_phase<EpiGU, MoeOrder, true, true>(F.lds, g, S, E, SMALLP(int, SM_ROWTOK));
}
__device__ __forceinline__ void phase_m4_fast(const Frame& F, int l) {
    using namespace pg8;
    moe_offsets(F, l);
    const LAS int* off = (const LAS int*)(F.lds + LDS_TAB);
    MoeOrder S{off[32] >> 8, 4, 256, F.bid, (const LAS int*)(F.lds + LDS_TAB + 512)};
    Gemm g{PTR(bf16, F_H), wl(F, l, WO_D), 0, 0, DE};
    EpiY E{PTR(bf16, F_Y)};
    gemm_phase<EpiY, MoeOrder, true, false>(F.lds, g, S, E, nullptr);
}

constexpr int N_PHASES = 1 + 9 * DEPTH;
struct Args { const float* in[19]; float* out; unsigned char* ws; int ph_lo, ph_hi, li, pad; };
__global__ void __launch_bounds__(NTHREADS, 2) mk_fwd(Args args) {
    extern __shared__ __attribute__((aligned(16))) unsigned char lds[];
    Frame F;
    F.lds = (LAS unsigned char*)lds;
    F.tid = threadIdx.x; F.lane = F.tid & 63; F.wave = __builtin_amdgcn_readfirstlane(F.tid >> 6);
    F.gtid = blockIdx.x * NTHREADS + F.tid; F.gw = blockIdx.x * NWAVES + F.wave; F.bid = blockIdx.x;
    if (F.tid == 0) {
#pragma unroll
        for (int i = 0; i < 19; ++i) ((LAS unsigned long long*)(F.lds + PARAM_OFF))[i] = (unsigned long long)args.in[i];
    }
    F.X = args.out; F.ws = args.ws; F.ctl = (unsigned*)(args.ws + WS_CTL);
    volatile LAS unsigned* MISC = (volatile LAS unsigned*)(F.lds + MISC_OFF);
    if (F.tid < 32) MISC[F.tid] = 0u;
    __syncthreads();
    XcdBarrier bar; bar.bar = F.ctl + CW_BAR; bar.x = 0; bar.st = nullptr;
    if (MK_N_LAUNCHES == 1) bar = xcd_barrier_post(F.ctl + CW_BAR, MISC + 8);
    const int lo = args.ph_lo, hi = args.ph_hi;
#define PH_ENTER() do { int t_ = threadIdx.x, b_ = blockIdx.x; asm volatile("" : "+v"(t_)); asm volatile("" : "+s"(b_)); F.tid = t_; F.lane = t_ & 63; F.bid = b_; F.gtid = b_ * NTHREADS + t_; \
        F.wave = __builtin_amdgcn_readfirstlane(t_ >> 6); F.gw = b_ * NWAVES + F.wave; F.X = args.out; F.ws = args.ws; F.ctl = (unsigned*)(args.ws + WS_CTL); \
        } while (0)
#ifndef PROBE_REP
#define PROBE_REP -1
#endif
#define RUNPH(k, call) do { if (lo <= (k) && (k) < hi) { PH_ENTER(); call; if ((k) == PROBE_REP || (PROBE_REP > 0 && PROBE_REP != 4 && (k) == PROBE_REP + 9)) { __syncthreads(); PH_ENTER(); call; } if ((k) + 1 < hi) { bar.bar = F.ctl + CW_BAR; xcd_barrier(bar); } } } while (0)
#define LAYER(l) do { \
        RUNPH(1 + 9 * (l) + 0, if (FAST_A1) phase_a1_fast(F, l); else phase_a1(F, l)); \
        RUNPH(1 + 9 * (l) + 1, if (FAST_A2) phase_a2_fast(F, l); else phase_a2(F, l)); \
        RUNPH(1 + 9 * (l) + 2, if (FAST_A3) phase_a3_fast(F, l); else phase_a3(F, l)); \
        RUNPH(1 + 9 * (l) + 3, if (FAST_A4) phase_a4_fast(F, l); else phase_a4(F, l)); \
        RUNPH(1 + 9 * (l) + 4, phase_m1(F, l)); \
        RUNPH(1 + 9 * (l) + 5, phase_m2(F, l)); \
        RUNPH(1 + 9 * (l) + 6, if (FAST_M3) phase_m3_fast(F, l); else phase_m3(F, l)); \
        RUNPH(1 + 9 * (l) + 7, if (FAST_M4) phase_m4_fast(F, l); else phase_m4(F, l)); \
        RUNPH(1 + 9 * (l) + 8, phase_m5(F, l)); } while (0)
    RUNPH(0, phase_p0(F));
#ifdef PROBE_XBAR
    if (lo == 0 && hi > 1) { for (int i_ = 0; i_ < PROBE_XBAR; ++i_) { bar.bar = F.ctl + CW_BAR; xcd_barrier(bar); } }
#endif
    LAYER(0);
    LAYER(1);
#undef LAYER
#undef RUNPH
#undef PH_ENTER
}

extern "C" void kernel_launch(void* const* d_in, const int* in_sizes, int n_in, void* d_out, int out_size, void* d_ws, size_t ws_size, hipStream_t stream) {
    static int ok = 0;
    if (ok == 0) {
        ok = 1;
        if (n_in != 19 || out_size != NTOK * DM || ws_size < F_END) { fprintf(stderr, "kernel_launch: unexpected shapes (n_in %d out %d ws %zu need %zu)\n", n_in, out_size, ws_size, (size_t)F_END); ok = -1; }
        if (hipFuncSetAttribute((const void*)mk_fwd, hipFuncAttributeMaxDynamicSharedMemorySize, LDS_BYTES) != hipSuccess) { fprintf(stderr, "kernel_launch: hipFuncSetAttribute failed\n"); ok = -1; }
    }
    if (ok < 0) return;
    (void)hipMemsetAsync((char*)d_ws + WS_CTL, 0, CTL_ZERO_BYTES, stream);
    Args a{};
    for (int i = 0; i < 19; ++i) a.in[i] = (const float*)d_in[i];
    a.out = (float*)d_out; a.ws = (unsigned char*)d_ws;
    if (MK_N_LAUNCHES == 1) { a.ph_lo = 0; a.ph_hi = N_PHASES; a.li = 0; hipLaunchKernelGGL(mk_fwd, dim3(256), dim3(NTHREADS), LDS_BYTES, stream, a); }
    else for (int p = 0; p < N_PHASES; ++p) { a.ph_lo = p; a.ph_hi = p + 1; a.li = p; hipLaunchKernelGGL(mk_fwd, dim3(256), dim3(NTHREADS), LDS_BYTES, stream, a); }
}
```
